# Optimizing an MI355X kernel written in HIP

```python
import math
import jax, jax.numpy as jnp
from jax import lax
import numpy as np

D_MODEL = 1024
BATCH = 16
SEQ = 4096
DEPTH = 1

CHUNK = 64
PLE_DIM = 256
ROPE_THETA = 10000.0
NORM_EPS = 1e-6

GLA_HEADS = 4
GLA_WIDTH = D_MODEL // 2
GLA_DK = GLA_WIDTH // 2 // GLA_HEADS
GLA_DV = GLA_WIDTH // GLA_HEADS
GLA_GATE_RANK = 16
GLA_GATE_NORM = 16.0

DIFF_HEADS = 4
DIFF_WIDTH = D_MODEL - GLA_WIDTH
DIFF_DV = DIFF_WIDTH // DIFF_HEADS
DIFF_DQK = DIFF_DV // 2
Q_BLOCK = 128

D_FF = 256 * ((8 * D_MODEL // 3 + 255) // 256)
CONV_W = 3

IN_SIZES = (GLA_HEADS * GLA_DK, GLA_HEADS * GLA_DK, GLA_WIDTH, GLA_WIDTH, GLA_GATE_RANK,
            DIFF_WIDTH, DIFF_WIDTH, DIFF_WIDTH)
IN_COLS = sum(IN_SIZES)

kernel_name = "hymba_gla_diffattn_convffn_ple"


def rms_norm(x, g):
    xf = x.astype(jnp.float32)
    y = xf * lax.rsqrt(jnp.mean(xf * xf, axis=-1, keepdims=True) + NORM_EPS)
    return (y * g.astype(jnp.float32)).astype(x.dtype)


def rope(x, pos):
    d = x.shape[-1]
    inv_freq = ROPE_THETA ** (-jnp.arange(0, d, 2, dtype=jnp.float32) / d)
    ang = pos.astype(jnp.float32)[..., None] * inv_freq
    cos, sin = jnp.cos(ang)[:, :, None, :], jnp.sin(ang)[:, :, None, :]
    xf = x.astype(jnp.float32)
    x1, x2 = xf[..., : d // 2], xf[..., d // 2:]
    return jnp.concatenate([x1 * cos - x2 * sin, x2 * cos + x1 * sin], axis=-1).astype(x.dtype)


def gla_mixer(q, k, v, g, a_low, w_a_up, b_a, norm_g):
    B, T = q.shape[:2]
    N = T // CHUNK
    H, dk, dv = GLA_HEADS, GLA_DK, GLA_DV
    qf = q.astype(jnp.float32).reshape(B, N, CHUNK, H, dk) * (dk ** -0.5)
    kf = k.astype(jnp.float32).reshape(B, N, CHUNK, H, dk)
    vf = v.astype(jnp.float32).reshape(B, N, CHUNK, H, dv)
    log_a = jax.nn.log_sigmoid((a_low @ w_a_up + b_a).astype(jnp.float32)) / GLA_GATE_NORM
    b = jnp.cumsum(log_a.reshape(B, N, CHUNK, H, dk), axis=2)
    b_last = b[:, :, -1:]
    eb, enb = jnp.exp(b), jnp.exp(-b)
    q_fwd = qf * eb
    a_fwd = jnp.einsum('bnthd,bnshd->bnhts', q_fwd, kf * enb)
    a_bwd = jnp.einsum('bnthd,bnshd->bnhts', qf * enb, kf * eb)
    tri = jnp.tril(jnp.ones((CHUNK, CHUNK), dtype=bool))
    a = jnp.where(tri, a_fwd, a_bwd)
    o_intra = jnp.einsum('bnhts,bnshv->bnthv', a, vf)
    d_state = jnp.einsum('bnshk,bnshv->bnhkv', kf * jnp.exp(b_last - b), vf)
    decay = jnp.exp(b_last[:, :, 0])

    def step(state, inp):
        dec, ds = inp
        return dec[..., None] * state + ds, state

    s0 = jnp.zeros((B, H, dk, dv), jnp.float32)
    _, s_prev = lax.scan(step, s0, (jnp.moveaxis(decay, 1, 0), jnp.moveaxis(d_state, 1, 0)))
    s_prev = jnp.moveaxis(s_prev, 0, 1)
    o_inter = jnp.einsum('bnthk,bnhkv->bnthv', q_fwd, s_prev)
    o = (o_intra + o_inter).reshape(B, T, H, dv)
    o = rms_norm(o, norm_g.reshape(H, dv)).reshape(B, T, H * dv)
    return (o * jax.nn.silu(g.astype(jnp.float32))).astype(q.dtype)


def diff_attention(q, k, v, pos, lam, lam_init, norm_g):
    B, T = q.shape[:2]
    H, dqk, dv = DIFF_HEADS, DIFF_DQK, DIFF_DV
    q = (rope(q.reshape(B, T, H * 2, dqk), pos) * (dqk ** -0.5)).reshape(B, T, H, 2, dqk)
    k = rope(k.reshape(B, T, H * 2, dqk), pos).reshape(B, T, H, 2, dqk)
    v = v.reshape(B, T, H, dv)
    outs = []
    for blk in range(T // Q_BLOCK):
        q0 = blk * Q_BLOCK
        k_end = q0 + Q_BLOCK
        s = jnp.einsum('bqhmd,bkhmd->bhmqk', q[:, q0:k_end], k[:, :k_end]).astype(jnp.float32)
        q_chunk = (q0 + jnp.arange(Q_BLOCK)) // CHUNK
        k_chunk = jnp.arange(k_end) // CHUNK
        mask = k_chunk[None, :] <= q_chunk[:, None]
        s = jnp.where(mask, s, jnp.float32(-1e30))
        pr = jax.nn.softmax(s, axis=-1)
        w = pr[:, :, 0] - lam * pr[:, :, 1]
        outs.append(jnp.einsum('bhqk,bkhd->bqhd', w.astype(v.dtype), v[:, :k_end]))
    o = jnp.concatenate(outs, axis=1)
    o = rms_norm(o, norm_g.reshape(H, dv)) * (1.0 - lam_init)
    return o.reshape(B, T, H * dv)


def conv_ffn(h, w_up, conv_w, conv_b, w_down):
    T = h.shape[1]
    u = h @ w_up
    up = jnp.pad(u, ((0, 0), (CONV_W - 1, 0), (0, 0)))
    c = conv_b + sum(up[:, j:j + T] * conv_w[j] for j in range(CONV_W))
    gate, val = jnp.split(c, 2, axis=-1)
    return (jax.nn.gelu(gate) * val) @ w_down


def setup_inputs(seed: int = 0) -> dict:
    key = jax.random.key(seed)
    ks = jax.random.split(key, 24)
    f32 = jnp.float32
    nrm = lambda k, shape, s: jax.random.normal(k, shape, f32) * s
    gain = lambda k, shape: 1.0 + 0.01 * jax.random.normal(k, shape, f32)
    x = jax.random.normal(ks[0], (BATCH, SEQ, D_MODEL), f32)
    p = jax.random.normal(ks[1], (DEPTH, BATCH, SEQ, PLE_DIM), f32)
    offsets = jax.random.randint(ks[2], (BATCH, 1), 0, 64, dtype=jnp.int32) * CHUNK
    positions = jnp.arange(SEQ, dtype=jnp.int32)[None, :] + offsets
    return {
        "x": x,
        "p": p,
        "positions": positions,
        "norm_mix": gain(ks[3], (DEPTH, D_MODEL)),
        "w_in": nrm(ks[4], (DEPTH, D_MODEL, IN_COLS), D_MODEL ** -0.5),
        "w_a_up": nrm(ks[5], (DEPTH, GLA_GATE_RANK, GLA_HEADS * GLA_DK), GLA_GATE_RANK ** -0.5),
        "b_a": nrm(ks[6], (DEPTH, GLA_HEADS * GLA_DK), 0.01),
        "gla_norm": gain(ks[7], (DEPTH, GLA_WIDTH)),
        "lam_q1": nrm(ks[8], (DEPTH, DIFF_DQK), 0.1),
        "lam_k1": nrm(ks[9], (DEPTH, DIFF_DQK), 0.1),
        "lam_q2": nrm(ks[10], (DEPTH, DIFF_DQK), 0.1),
        "lam_k2": nrm(ks[11], (DEPTH, DIFF_DQK), 0.1),
        "diff_norm": gain(ks[12], (DEPTH, DIFF_WIDTH)),
        "w_out": nrm(ks[13], (DEPTH, D_MODEL, D_MODEL), D_MODEL ** -0.5),
        "norm_ffn": gain(ks[14], (DEPTH, D_MODEL)),
        "w_up": nrm(ks[15], (DEPTH, D_MODEL, 2 * D_FF), D_MODEL ** -0.5),
        "conv_w": nrm(ks[16], (DEPTH, CONV_W, 2 * D_FF), CONV_W ** -0.5),
        "conv_b": nrm(ks[17], (DEPTH, 2 * D_FF), 0.01),
        "w_down": nrm(ks[18], (DEPTH, D_FF, D_MODEL), D_FF ** -0.5),
        "norm_ple": gain(ks[19], (DEPTH, D_MODEL)),
        "w_ple_gate": nrm(ks[20], (DEPTH, D_MODEL, D_MODEL), D_MODEL ** -0.5),
        "w_ple_proj": nrm(ks[21], (DEPTH, PLE_DIM, D_MODEL), PLE_DIM ** -0.5),
        "norm_final": gain(ks[22], (D_MODEL,)),
    }


def reference(x, p, positions, norm_mix, w_in, w_a_up, b_a, gla_norm, lam_q1, lam_k1, lam_q2, lam_k2,
              diff_norm, w_out, norm_ffn, w_up, conv_w, conv_b, w_down, norm_ple, w_ple_gate,
              w_ple_proj, norm_final):
    split_points = [int(s) for s in np.cumsum(IN_SIZES)[:-1]]
    h = x
    for i in range(DEPTH):
        u = rms_norm(h, norm_mix[i])
        z = u @ w_in[i]
        gq, gk, gv, gg, ga, dq, dk, dv = jnp.split(z, split_points, axis=-1)
        o_gla = gla_mixer(gq, gk, gv, gg, ga, w_a_up[i], b_a[i], gla_norm[i])
        lam_init = 0.8 - 0.6 * math.exp(-0.3 * i)
        lam = (jnp.exp(jnp.sum(lam_q1[i].astype(jnp.float32) * lam_k1[i].astype(jnp.float32)))
               - jnp.exp(jnp.sum(lam_q2[i].astype(jnp.float32) * lam_k2[i].astype(jnp.float32)))
               + lam_init)
        o_diff = diff_attention(dq, dk, dv, positions, lam, lam_init, diff_norm[i])
        h = h + jnp.concatenate([o_gla, o_diff], axis=-1) @ w_out[i]
        h = h + conv_ffn(rms_norm(h, norm_ffn[i]), w_up[i], conv_w[i], conv_b[i], w_down[i])
        gate = jax.nn.sigmoid(rms_norm(h, norm_ple[i]) @ w_ple_gate[i])
        h = h + gate * (p[i] @ w_ple_proj[i])
    return rms_norm(h, norm_final)
```

```cpp
#include <hip/hip_runtime.h>
#include <hip/hip_bf16.h>
#include <hip/hip_cooperative_groups.h>
#include <cstdio>
namespace cg = cooperative_groups;

typedef unsigned short u16;
using bf16x8 = __attribute__((ext_vector_type(8))) short;
using s16x4  = __attribute__((ext_vector_type(4))) short;
using f32x4  = __attribute__((ext_vector_type(4))) float;
using f32x16 = __attribute__((ext_vector_type(16))) float;
#define DI __device__ __forceinline__
#ifndef PROBE_REP
#define PROBE_REP 0
#endif

constexpr int NTOK = 65536, DM = 1024, SEQL = 4096;
constexpr int NIN = 3072, NFF = 2816, NUP = 5632;
constexpr float EPS = 1e-6f;
constexpr int SMEM_BYTES = 139264;
constexpr int SMEM_ITEM_OFF = 139008;

constexpr size_t OFF_WIN  = 0;
constexpr size_t OFF_WOUT = OFF_WIN  + (size_t)3072 * 1024 * 2;
constexpr size_t OFF_WUP  = OFF_WOUT + (size_t)1024 * 1024 * 2;
constexpr size_t OFF_WDN  = OFF_WUP  + (size_t)5632 * 1024 * 2;
constexpr size_t OFF_WPG  = OFF_WDN  + (size_t)1024 * 2816 * 2;
constexpr size_t OFF_WPP  = OFF_WPG  + (size_t)1024 * 1024 * 2;
constexpr size_t OFF_PB   = OFF_WPP  + (size_t)1024 * 256 * 2;
constexpr size_t OFF_U0   = OFF_PB   + (size_t)NTOK * 256 * 2;
constexpr size_t OFF_ZB   = OFF_U0   + (size_t)NTOK * 1024 * 2;
constexpr size_t OFF_VTG  = OFF_ZB   + (size_t)NTOK * 3072 * 2;
constexpr size_t OFF_VTD  = OFF_VTG  + (size_t)NTOK * 512 * 2;
constexpr size_t OFF_ALOW = OFF_VTD  + (size_t)NTOK * 512 * 2;
constexpr size_t OFF_ROPE = OFF_ALOW + (size_t)NTOK * 16 * 4;
constexpr size_t OFF_OB   = OFF_ROPE + (size_t)NTOK * 32 * 8;
constexpr size_t OFF_HALO = OFF_OB   + (size_t)NTOK * 1024 * 2;
constexpr size_t OFF_SSQ1 = OFF_HALO + (size_t)256 * 4 * 5632 * 4;
constexpr size_t OFF_SSQ2 = OFF_SSQ1 + (size_t)NTOK * 16 * 4;
constexpr size_t OFF_SSQ3 = OFF_SSQ2 + (size_t)NTOK * 16 * 4;
constexpr size_t OFF_CNT  = OFF_SSQ3 + (size_t)NTOK * 16 * 4;
constexpr size_t OFF_BCUM = OFF_CNT  + 256;
constexpr size_t OFF_KDT  = OFF_BCUM + (size_t)NTOK * 256 * 4;
constexpr size_t OFF_ARR  = OFF_KDT  + (size_t)NTOK * 256 * 2;
constexpr size_t OFF_XB   = OFF_ARR  + 4096;
constexpr size_t OFF_SLOT = OFF_XB   + 16384;

struct Params {
  const float* x; const float* p; const int* pos;
  const float* norm_mix; const float* w_in; const float* w_a_up; const float* b_a; const float* gla_norm;
  const float* lq1; const float* lk1; const float* lq2; const float* lk2; const float* diff_norm;
  const float* w_out; const float* norm_ffn; const float* w_up; const float* conv_w; const float* conv_b;
  const float* w_down; const float* norm_ple; const float* w_pg; const float* w_pp; const float* norm_final;
  float* out; char* ws;
};

extern __shared__ __attribute__((aligned(16))) char smem[];

DI int tid_fresh(const int wv) {
  int l;
  asm volatile("v_mbcnt_lo_u32_b32 %0, -1, 0\n\tv_mbcnt_hi_u32_b32 %0, -1, %0" : "=v"(l));
  return wv * 64 + l;
}
typedef __bf16 bf16v2_t __attribute__((ext_vector_type(2)));
typedef float f32v2_t __attribute__((ext_vector_type(2)));
DI unsigned pack2(float a, float b) { f32v2_t v = {a, b}; return __builtin_bit_cast(unsigned, __builtin_convertvector(v, bf16v2_t)); }
DI u16 f2bf(float f) { return __builtin_bit_cast(u16, (__bf16)f); }
DI float bf2f(u16 h) { return __uint_as_float(((unsigned)h) << 16); }
DI uint4 pack8(const float* a, const float* b) {
  uint4 r; r.x = pack2(a[0], a[1]); r.y = pack2(a[2], a[3]); r.z = pack2(b[0], b[1]); r.w = pack2(b[2], b[3]); return r;
}
DI s16x4 pack4(float a, float b, float c, float d) {
  uint2 r; r.x = pack2(a, b); r.y = pack2(c, d); return __builtin_bit_cast(s16x4, r);
}
DI float xor32_sum(float x) { auto r = __builtin_amdgcn_permlane32_swap(__float_as_uint(x), __float_as_uint(x), false, false); return __uint_as_float(r[0]) + __uint_as_float(r[1]); }
DI float xor32_max(float x) { auto r = __builtin_amdgcn_permlane32_swap(__float_as_uint(x), __float_as_uint(x), false, false); return fmaxf(__uint_as_float(r[0]), __uint_as_float(r[1])); }
DI float xor16_sum(float x) { auto r = __builtin_amdgcn_permlane16_swap(__float_as_uint(x), __float_as_uint(x), false, false); return __uint_as_float(r[0]) + __uint_as_float(r[1]); }
DI void lds_barrier() { asm volatile("s_waitcnt lgkmcnt(0)" ::: "memory"); __builtin_amdgcn_s_barrier(); asm volatile("" ::: "memory"); }
DI float rs4(const float* __restrict__ ssq, int row) {
  const float4 a = *reinterpret_cast<const float4*>(ssq + (size_t)row * 4);
  return rsqrtf(((a.x + a.y) + (a.z + a.w)) * (1.0f / 1024.0f) + EPS);
}
DI float rs_from(const float* __restrict__ ssq, int row) {
  const float4* q = reinterpret_cast<const float4*>(ssq + (size_t)row * 16);
  float4 a = q[0], b = q[1], c = q[2], d = q[3];
  float s = (a.x + a.y + a.z + a.w) + (b.x + b.y + b.z + b.w) + (c.x + c.y + c.z + c.w) + (d.x + d.y + d.z + d.w);
  return rsqrtf(s * (1.0f / 1024.0f) + EPS);
}
DI float gelu_tanh(float x) {
  const float y2 = 1.5957691216057308f * (x + 0.044715f * x * x * x);
  return x * __builtin_amdgcn_rcpf(1.0f + __expf(-y2));
}


#define XB_TMO      128
#define XB_XCNT(j)  (256  + 64 * (j))
#define XB_XSUB(j)  (1280 + 64 * (j))
#define XB_XGEN(j)  (2304 + 64 * (j))
#define XB_TOP      3328
#define XB_TOPGEN   3392
#define XCD_BAR_WORDS 3456
#define XB_SPIN_CAP (1u << 18)
#define LAS __attribute__((address_space(3)))
DI unsigned xb_ld(unsigned* p)              { return __hip_atomic_load(p, __ATOMIC_RELAXED, __HIP_MEMORY_SCOPE_AGENT); }
DI unsigned xb_add(unsigned* p, unsigned v) { return __hip_atomic_fetch_add(p, v, __ATOMIC_RELAXED, __HIP_MEMORY_SCOPE_AGENT); }
DI unsigned xb_xcc_id() { return (unsigned)__builtin_amdgcn_s_getreg((3 << 11) | 20) & 0xFu; }
#define XB_SPIN(cond, bar) do { unsigned _sp = 0; while (cond) { __builtin_amdgcn_s_sleep(1); \
    if ((++_sp & 255u) == 0u) { if (xb_ld(&(bar)[XB_TMO])) break; if (_sp > XB_SPIN_CAP) { atomicAdd(&(bar)[XB_TMO], 1u); break; } } } } while (0)
struct XcdBarrier { unsigned* bar; unsigned x; volatile LAS unsigned* st; };
DI XcdBarrier xcd_barrier_post(unsigned* bar, volatile LAS unsigned* st, const int wv) {
  XcdBarrier b; b.bar = bar; b.x = xb_xcc_id(); b.st = st;
  if (tid_fresh(wv) == 0) (void)xb_add(&bar[XB_XCNT(b.x)], 1u);
  return b;
}
DI void xcd_barrier_complete(unsigned* bar, unsigned x, unsigned& nloc, unsigned& nx) {
  const unsigned G = gridDim.x * gridDim.y * gridDim.z;
  unsigned sum, cnt, mine, sp = 0u;
  for (;;) {
    sum = 0u; cnt = 0u; mine = 0u;
#pragma unroll
    for (unsigned j = 0; j < 16; ++j) { const unsigned c = xb_ld(&bar[XB_XCNT(j)]); sum += c; cnt += (c > 0u) ? 1u : 0u; mine = (j == x) ? c : mine; }
    if (sum == G) break;
    __builtin_amdgcn_s_sleep(1);
    if ((++sp & 255u) == 0u) { if (xb_ld(&bar[XB_TMO])) break; if (sp > XB_SPIN_CAP) { atomicAdd(&bar[XB_TMO], 1u); break; } }
  }
  nloc = mine > 0u ? mine : 1u; nx = cnt > 0u ? cnt : 1u;
}
DI void xcd_barrier(const XcdBarrier& b, const int wv) {
  asm volatile("s_waitcnt vmcnt(0)" ::: "memory");
  __syncthreads();
  if (tid_fresh(wv) == 0) {
    unsigned* bar = b.bar;
    __builtin_amdgcn_s_waitcnt(0);
    unsigned nloc = b.st[0], nx = b.st[1];
    if (nloc == 0u) { xcd_barrier_complete(bar, b.x, nloc, nx); b.st[0] = nloc; b.st[1] = nx; }
    const unsigned old = xb_add(&bar[XB_XSUB(b.x)], 1u);
    const unsigned gen = old / nloc;
    if (old + 1u == (gen + 1u) * nloc) {
      __builtin_amdgcn_fence(__ATOMIC_RELEASE, "agent");
      asm volatile("s_waitcnt vmcnt(0)" ::: "memory");
      const unsigned og = xb_add(&bar[XB_TOP], 1u);
      const unsigned tg = og / nx;
      if (og + 1u == (tg + 1u) * nx) xb_add(&bar[XB_TOPGEN], 1u);
      else XB_SPIN(xb_ld(&bar[XB_TOPGEN]) == tg, bar);
      __builtin_amdgcn_fence(__ATOMIC_ACQUIRE, "agent");
      xb_add(&bar[XB_XGEN(b.x)], 1u);
      asm volatile("s_waitcnt vmcnt(0)" ::: "memory");
    } else {
      XB_SPIN(xb_ld(&bar[XB_XGEN(b.x)]) == gen, bar);
      __builtin_amdgcn_fence(__ATOMIC_ACQUIRE, "agent");
      asm volatile("s_waitcnt vmcnt(0)" ::: "memory");
    }
  }
  __syncthreads();
}

DI int src_col_in(int n) {
  if (n < 1536) return n;
  if (n < 2560) {
    int g = (n - 1536) >> 6, pc = (n - 1536) & 63, s = pc >> 5, w = pc & 31;
    int d = s * 16 + (w >> 3) * 4 + (w & 3) + 32 * ((w >> 2) & 1);
    return 1552 + g * 64 + d;
  }
  return n + 16;
}
DI int src_col_up(int n) { return ((n >> 7) & 1) * 2816 + (n >> 8) * 128 + (n & 127); }

__device__ void phase_prep(const Params& p, const int wv) {
  const int tid = tid_fresh(wv);
  u16* ws16 = reinterpret_cast<u16*>(p.ws);
  if (blockIdx.x == 0 && tid < 32) reinterpret_cast<int*>(p.ws + OFF_CNT)[tid] = 0;
  if (blockIdx.x == 0) for (int e = tid; e < XCD_BAR_WORDS; e += 512) reinterpret_cast<unsigned*>(p.ws + OFF_XB)[e] = 0u;
  {
    uint4* sl = reinterpret_cast<uint4*>(p.ws + OFF_SLOT);
    for (int e = blockIdx.x * 512 + tid; e < NTOK * 16 / 2; e += gridDim.x * 512) sl[e] = make_uint4(0u, 0u, 0u, 0u);
  }
  {
    float* tl = reinterpret_cast<float*>(smem);
    const int T0 = 768, T1 = T0 + 256, T2 = T1 + 1408, T3 = T2 + 704, T4 = T3 + 256, T5 = T4 + 64;
    for (int grp = blockIdx.x; grp < T5 / 4; grp += gridDim.x) {
      float v[4][8];
      __syncthreads();
#pragma unroll
      for (int q = 0; q < 4; ++q) {
        const int tile = grp * 4 + q;
        const float* src; const float* scale = nullptr; int K, Nsrc, job, lt;
        if (tile < T0)      { job = 0; lt = tile;      src = p.w_in;   K = 1024; Nsrc = 3088; }
        else if (tile < T1) { job = 1; lt = tile - T0; src = p.w_out;  K = 1024; Nsrc = 1024; }
        else if (tile < T2) { job = 2; lt = tile - T1; src = p.w_up;   K = 1024; Nsrc = 5632; scale = p.norm_ffn; }
        else if (tile < T3) { job = 3; lt = tile - T2; src = p.w_down; K = 2816; Nsrc = 1024; }
        else if (tile < T4) { job = 4; lt = tile - T3; src = p.w_pg;   K = 1024; Nsrc = 1024; scale = p.norm_ple; }
        else                { job = 5; lt = tile - T4; src = p.w_pp;   K = 256;  Nsrc = 1024; }
        const int nkt = K >> 6;
        const int n0 = (lt / nkt) * 64, k0 = (lt % nkt) * 64;
        const int n = n0 + (tid & 63);
        const int sc = (job == 0) ? src_col_in(n) : ((job == 2) ? src_col_up(n) : n);
#pragma unroll
        for (int i = 0; i < 8; ++i) {
          const int kk = (tid >> 6) + 8 * i;
          float x = src[(size_t)(k0 + kk) * Nsrc + sc];
          if (scale) x *= scale[k0 + kk];
          v[q][i] = x;
        }
      }
#pragma unroll
      for (int q = 0; q < 4; ++q)
#pragma unroll
        for (int i = 0; i < 8; ++i) tl[q * 4160 + (tid & 63) * 65 + (tid >> 6) + 8 * i] = v[q][i];
      __syncthreads();
#pragma unroll
      for (int q = 0; q < 4; ++q) {
        const int tile = grp * 4 + q;
        u16* dst; int K, lt;
        if (tile < T0)      { lt = tile;      dst = ws16 + OFF_WIN / 2;  K = 1024; }
        else if (tile < T1) { lt = tile - T0; dst = ws16 + OFF_WOUT / 2; K = 1024; }
        else if (tile < T2) { lt = tile - T1; dst = ws16 + OFF_WUP / 2;  K = 1024; }
        else if (tile < T3) { lt = tile - T2; dst = ws16 + OFF_WDN / 2;  K = 2816; }
        else if (tile < T4) { lt = tile - T3; dst = ws16 + OFF_WPG / 2;  K = 1024; }
        else                { lt = tile - T4; dst = ws16 + OFF_WPP / 2;  K = 256; }
        const int nkt = K >> 6;
        const int n0 = (lt / nkt) * 64, k0 = (lt % nkt) * 64;
        const int kk = tid & 63;
#pragma unroll
        for (int i = 0; i < 8; ++i) {
          const int nn = (tid >> 6) + 8 * i;
          dst[(size_t)(n0 + nn) * K + k0 + kk] = f2bf(tl[q * 4160 + nn * 65 + kk]);
        }
      }
    }
    __syncthreads();
  }
  {
    u16* pb = ws16 + OFF_PB / 2;
    const size_t ngrp = (size_t)NTOK * 256 / 8;
    const size_t stride = (size_t)gridDim.x * 512;
    for (size_t g0 = (size_t)blockIdx.x * 512 + tid; g0 < ngrp; g0 += 4 * stride) {
      float4 a[4], b[4];
#pragma unroll
      for (int q = 0; q < 4; ++q) {
        const size_t g = g0 + q * stride;
        if (g < ngrp) { const float4* sp = reinterpret_cast<const float4*>(p.p + g * 8); a[q] = sp[0]; b[q] = sp[1]; }
      }
#pragma unroll
      for (int q = 0; q < 4; ++q) {
        const size_t g = g0 + q * stride;
        if (g < ngrp) {
          uint4 o;
          o.x = pack2(a[q].x, a[q].y); o.y = pack2(a[q].z, a[q].w); o.z = pack2(b[q].x, b[q].y); o.w = pack2(b[q].z, b[q].w);
          *reinterpret_cast<uint4*>(pb + g * 8) = o;
        }
      }
    }
  }
  {
    u16* UL = reinterpret_cast<u16*>(smem);
    u16* WG = reinterpret_cast<u16*>(smem + 66048);
    float* AL = reinterpret_cast<float*>(smem + 99072);
    float* HTOT = reinterpret_cast<float*>(smem + 103168);
    for (int e = tid; e < 16 * 1024; e += 512) {
      const int r = e & 15, k = e >> 4;
      WG[r * 1032 + k] = f2bf(p.w_in[(size_t)k * 3088 + 1536 + r]);
    }
    __syncthreads();
    const int wave = tid >> 6, lane = tid & 63;
    u16* u0 = ws16 + OFF_U0 / 2;
    float2* rope = reinterpret_cast<float2*>(p.ws + OFF_ROPE);
    float* bcum = reinterpret_cast<float*>(p.ws + OFF_BCUM);
    const int gc = tid & 255, hf = tid >> 8;
    float wcol[16];
#pragma unroll
    for (int r = 0; r < 16; ++r) wcol[r] = p.w_a_up[r * 256 + gc];
    const float bac = p.b_a[gc];
    for (int ch = blockIdx.x; ch < NTOK / 64; ch += gridDim.x) {
#pragma unroll 1
      for (int half = 0; half < 2; ++half) {
        float4 xa[4][4];
#pragma unroll
        for (int rq = 0; rq < 4; ++rq)
#pragma unroll
          for (int i = 0; i < 4; ++i)
            xa[rq][i] = *reinterpret_cast<const float4*>(p.x + (size_t)(ch * 64 + half * 32 + wave * 4 + rq) * 1024 + i * 256 + lane * 4);
#pragma unroll
        for (int rq = 0; rq < 4; ++rq) {
          const int rl = wave * 4 + rq;
          const int row = ch * 64 + half * 32 + rl;
          float4 xv[4];
          float ss = 0.f;
#pragma unroll
          for (int i = 0; i < 4; ++i) {
            xv[i] = xa[rq][i];
            ss += xv[i].x * xv[i].x + xv[i].y * xv[i].y + xv[i].z * xv[i].z + xv[i].w * xv[i].w;
          }
#pragma unroll
          for (int o = 32; o >= 1; o >>= 1) ss += __shfl_xor(ss, o);
          const float r = rsqrtf(ss * (1.0f / 1024.0f) + EPS);
#pragma unroll
          for (int i = 0; i < 4; ++i) {
            const float4 g = *reinterpret_cast<const float4*>(p.norm_mix + i * 256 + lane * 4);
            const s16x4 pk = pack4(xv[i].x * r * g.x, xv[i].y * r * g.y, xv[i].z * r * g.z, xv[i].w * r * g.w);
            *reinterpret_cast<s16x4*>(u0 + (size_t)row * 1024 + i * 256 + lane * 4) = pk;
            *reinterpret_cast<s16x4*>(UL + rl * 1032 + i * 256 + lane * 4) = pk;
          }
          if (lane >= 32) {
            const int f = lane - 32;
            const float invf = exp2f(-(float)f * (13.287712379549449f / 32.0f));
            const float ang = (float)p.pos[row] * invf;
            const double a = (double)ang;
            const double n = rint(a * 0.15915494309189535);
            const float red = (float)(a - n * 6.283185307179586);
            rope[(size_t)row * 32 + f] = make_float2(__cosf(red), __sinf(red));
          }
        }
        lds_barrier();
        if (wave < 2) {
          const int fr = lane & 15, fq = lane >> 4;
          f32x4 c0 = f32x4{0.f, 0.f, 0.f, 0.f}, c1 = f32x4{0.f, 0.f, 0.f, 0.f};
#pragma unroll 4
          for (int k0 = 0; k0 < 1024; k0 += 64) {
            const bf16x8 a0 = *reinterpret_cast<const bf16x8*>(UL + (wave * 16 + fr) * 1032 + k0 + fq * 8);
            const bf16x8 b0 = *reinterpret_cast<const bf16x8*>(WG + fr * 1032 + k0 + fq * 8);
            const bf16x8 a1 = *reinterpret_cast<const bf16x8*>(UL + (wave * 16 + fr) * 1032 + k0 + 32 + fq * 8);
            const bf16x8 b1 = *reinterpret_cast<const bf16x8*>(WG + fr * 1032 + k0 + 32 + fq * 8);
            c0 = __builtin_amdgcn_mfma_f32_16x16x32_bf16(a0, b0, c0, 0, 0, 0);
            c1 = __builtin_amdgcn_mfma_f32_16x16x32_bf16(a1, b1, c1, 0, 0, 0);
          }
#pragma unroll
          for (int j = 0; j < 4; ++j) AL[(half * 32 + wave * 16 + fq * 4 + j) * 16 + fr] = c0[j] + c1[j];
        }
        lds_barrier();
      }
      lds_barrier();
      float cum[32];
      float run = 0.f;
#pragma unroll
      for (int t = 0; t < 32; ++t) {
        float lg = bac;
#pragma unroll
        for (int r = 0; r < 16; ++r) lg += AL[(hf * 32 + t) * 16 + r] * wcol[r];
        const float ls = fminf(lg, 0.f) - __logf(1.0f + __expf(-fabsf(lg)));
        run += ls * (1.0f / 16.0f);
        cum[t] = run;
      }
      if (hf == 0) HTOT[gc] = run;
      lds_barrier();
      const float off = hf ? HTOT[gc] : 0.f;
#pragma unroll
      for (int t = 0; t < 32; ++t) bcum[(size_t)(ch * 64 + hf * 32 + t) * 256 + gc] = cum[t] + off;
    }
    __syncthreads();
  }
}

constexpr int BM = 256, BK = 64, HALF = 128, HT = HALF * BK;
DI int lds_byte(int r, int c) {
  int st = (r >> 4) * 2 + (c >> 5), rr = r & 15, cc = c & 31, ob = rr * 64 + cc * 2;
  return st * 1024 + (ob ^ (((ob >> 9) & 1) << 5));
}
DI void stage_rc(int b, int& R, int& C) {
  int st = b / 1024, sb = b % 1024, swz = sb ^ (((sb >> 9) & 1) << 5);
  R = (st >> 1) * 16 + swz / 64; C = (st & 1) * 32 + (swz % 64) / 2;
}

__device__ void phase_final_rows(const Params& p, const int wv, const int row0);
enum { EPI_IN = 0, EPI_RES = 1, EPI_UP = 2, EPI_PP = 3, EPI_PLE = 4, EPI_NONE = 5 };

struct EpiArgs {
  const float* res;
  float* ssq_out;
  const float* ssq_in;
};

template <int EPI, bool FUSED = true>
__device__ __forceinline__ void gemm_tile(const u16* __restrict__ A, const u16* __restrict__ Bt, const int K,
                                          const int brow, const int bcol, const Params& p, const EpiArgs& ea, const int wv,
                                          const bool pro_done, const bool has_next, const int nbrow, const int nbcol) {
  u16* shm = reinterpret_cast<u16*>(smem);
#define SA(b, h) (shm + ((b) * 2 + (h)) * HT)
#define SB(b, h) (shm + (4 + (b) * 2 + (h)) * HT)
#define STAGE(P, BASE, br, kt) do { const size_t _g = (size_t)(br) * K + (size_t)(kt) * BK; \
    _Pragma("unroll") for (int _i = 0; _i < 2; ++_i) { int _b = tidK * 16 + _i * 8192; int _r, _c; stage_rc(_b, _r, _c); \
      __builtin_amdgcn_global_load_lds((const unsigned*)(BASE + _g + (size_t)_r * K + _c), \
        (unsigned*)((char*)(P) + _b), 16, 0, 0); } } while (0)
#define STAGEB(P, BASE, br, kt) do { const size_t _g = (size_t)(br) * K + (size_t)(kt) * BK; \
    _Pragma("unroll") for (int _i = 0; _i < 2; ++_i) { int _b = tidK * 16 + _i * 8192; int _r, _c; stage_rc(_b, _r, _c); \
      const int _rho = _r & 31; _r = (_r & ~31) | (8 * ((_rho & 15) >> 2) + 4 * (_rho >> 4) + (_rho & 3)); \
      __builtin_amdgcn_global_load_lds((const unsigned*)(BASE + _g + (size_t)_r * K + _c), \
        (unsigned*)((char*)(P) + _b), 16, 0, 0); } } while (0)
#define LDA(dst, b, h) _Pragma("unroll") for (int m = 0; m < 4; ++m) _Pragma("unroll") for (int k = 0; k < 2; ++k) \
    dst[m][k] = *reinterpret_cast<const bf16x8*>((char*)SA(b, h) + lds_byte(wr * 64 + m * 16 + fr, k * 32 + fq * 8))
#define LDB(dst, b, h) _Pragma("unroll") for (int n = 0; n < 2; ++n) _Pragma("unroll") for (int k = 0; k < 2; ++k) \
    dst[n][k] = *reinterpret_cast<const bf16x8*>((char*)SB(b, h) + lds_byte(wc * 32 + n * 16 + fr, k * 32 + fq * 8))
#define MMA(ai, bj, At_, Bt_) do { __builtin_amdgcn_s_setprio(1); \
    _Pragma("unroll") for (int m = 0; m < 4; ++m) _Pragma("unroll") for (int n = 0; n < 2; ++n) _Pragma("unroll") for (int k = 0; k < 2; ++k) \
      acc[ai][bj][m][n] = __builtin_amdgcn_mfma_f32_16x16x32_bf16(Bt_[n][k], At_[m][k], acc[ai][bj][m][n], 0, 0, 0); \
    __builtin_amdgcn_s_setprio(0); } while (0)
#define WAIT_V(n) asm volatile("s_waitcnt vmcnt(" #n ")" ::: "memory")
#define WAIT_L(n) asm volatile("s_waitcnt lgkmcnt(" #n ")" ::: "memory")
#define BAR __builtin_amdgcn_s_barrier()
#define SCHED __builtin_amdgcn_sched_barrier(0)

  f32x4 acc[2][2][4][2];
  {
  const int tidK = tid_fresh(wv);
  const int wid = tidK >> 6, lane = tidK & 63, wr = wid >> 2, wc = wid & 3, fr = lane & 15, fq = lane >> 4;
#pragma unroll
  for (int a = 0; a < 2; ++a)
#pragma unroll
    for (int b = 0; b < 2; ++b)
#pragma unroll
      for (int m = 0; m < 4; ++m)
#pragma unroll
        for (int n = 0; n < 2; ++n) acc[a][b][m][n] = f32x4{0.f, 0.f, 0.f, 0.f};
  bf16x8 At[4][2], B0[2][2], B1[2][2];
  const int nt = K / BK;
  if (!pro_done) {
    STAGEB(SB(0, 0), Bt, bcol, 0); STAGE(SA(0, 0), A, brow, 0);
    STAGEB(SB(0, 1), Bt, bcol + HALF, 0); STAGE(SA(0, 1), A, brow + HALF, 0);
  }
  if (wr == 1) BAR;
  WAIT_V(4); BAR;
  STAGEB(SB(1, 0), Bt, bcol, 1); STAGE(SA(1, 0), A, brow, 1); STAGEB(SB(1, 1), Bt, bcol + HALF, 1);
  WAIT_V(6); BAR;
  for (int t = 0; t < nt - 2; t += 2) {
    LDB(B0, 0, 0); SCHED; LDA(At, 0, 0); STAGE(SA(1, 1), A, brow + HALF, t + 1);
    WAIT_L(8); BAR; WAIT_L(0); MMA(0, 0, At, B0); BAR; SCHED;
    LDB(B1, 0, 1); STAGEB(SB(0, 0), Bt, bcol, t + 2);
    BAR; WAIT_L(0); MMA(0, 1, At, B1); BAR;
    LDA(At, 0, 1); STAGE(SA(0, 0), A, brow, t + 2);
    BAR; WAIT_L(0); MMA(1, 0, At, B0); BAR; SCHED;
    STAGEB(SB(0, 1), Bt, bcol + HALF, t + 2);
    WAIT_V(6); BAR; MMA(1, 1, At, B1); BAR;
    LDB(B0, 1, 0); SCHED; LDA(At, 1, 0); STAGE(SA(0, 1), A, brow + HALF, t + 2);
    WAIT_L(8); BAR; WAIT_L(0); MMA(0, 0, At, B0); BAR; SCHED;
    LDB(B1, 1, 1); STAGEB(SB(1, 0), Bt, bcol, t + 3);
    BAR; WAIT_L(0); MMA(0, 1, At, B1); BAR;
    LDA(At, 1, 1); STAGE(SA(1, 0), A, brow, t + 3);
    BAR; WAIT_L(0); MMA(1, 0, At, B0); BAR; SCHED;
    STAGEB(SB(1, 1), Bt, bcol + HALF, t + 3);
    WAIT_V(6); BAR; MMA(1, 1, At, B1); BAR;
  }
  { LDB(B0, 0, 0); LDA(At, 0, 0); STAGE(SA(1, 1), A, brow + HALF, nt - 1);
    BAR; WAIT_L(0); MMA(0, 0, At, B0); BAR;
    LDB(B1, 0, 1); BAR; WAIT_L(0); MMA(0, 1, At, B1); BAR;
    LDA(At, 0, 1); WAIT_V(4); BAR; WAIT_L(0); MMA(1, 0, At, B0); MMA(1, 1, At, B1); BAR; }
  { LDB(B0, 1, 0); LDA(At, 1, 0); WAIT_V(2); BAR; WAIT_L(0); MMA(0, 0, At, B0); BAR;
    LDB(B1, 1, 1); WAIT_V(0); BAR; WAIT_L(0); MMA(0, 1, At, B1); BAR;
    LDA(At, 1, 1); BAR; WAIT_L(0); MMA(1, 0, At, B0); MMA(1, 1, At, B1); BAR; }
  if (wr == 0) BAR;
  if (has_next) {
    const int tidK = tid_fresh(wv);
    STAGEB(SB(0, 0), Bt, nbcol, 0); STAGE(SA(0, 0), A, nbrow, 0);
    STAGEB(SB(0, 1), Bt, nbcol + HALF, 0); STAGE(SA(0, 1), A, nbrow + HALF, 0);
  }
  }
  const int tidE = tid_fresh(wv);
  const int wr = tidE >> 8, wc = (tidE >> 6) & 3, fr = tidE & 15, fq = (tidE >> 4) & 3;
#undef SA
#undef SB
#undef STAGE
#undef STAGEB
#undef LDA
#undef LDB
#undef MMA

  u16* ws16 = reinterpret_cast<u16*>(p.ws);
  if constexpr (EPI == EPI_IN) {
    const int ntile = bcol >> 8;
    u16* zb = ws16 + OFF_ZB / 2;
    if (ntile == 2 || ntile == 3 || ntile == 10 || ntile == 11) {
      u16* vt = ws16 + ((ntile < 4) ? OFF_VTG : OFF_VTD) / 2;
      const int cbase = (ntile < 4) ? 512 : 2560;
      u16* Tt = reinterpret_cast<u16*>(smem);
      lds_barrier();
#pragma unroll
      for (int ai = 0; ai < 2; ++ai)
#pragma unroll
        for (int m = 0; m < 4; ++m) {
          SCHED; const int tl = ai * 128 + wr * 64 + m * 16 + fr;
#pragma unroll
          for (int bj = 0; bj < 2; ++bj)
#pragma unroll
            for (int n = 0; n < 2; ++n) {
              const int cl = bj * 128 + wc * 32 + fq * 8 + n * 4;
#pragma unroll
              for (int j = 0; j < 4; ++j) Tt[(cl + j) * 264 + tl] = f2bf(acc[ai][bj][m][n][j]);
            }
        }
      lds_barrier();
      {
        const int bq = brow >> 12, t0 = brow & 4095;
#pragma unroll 4
        for (int i = 0; i < 16; ++i) {
          const int L = i * 512 + tidE, c = L >> 5, ch = L & 31;
          const int cv = bcol - cbase + c;
          const bf16x8 v = *reinterpret_cast<const bf16x8*>(Tt + c * 264 + ch * 8);
          *reinterpret_cast<bf16x8*>(vt + ((size_t)((bq * 4 + (cv >> 7)) * 128 + (cv & 127))) * 4096 + t0 + ch * 8) = v;
        }
      }
      lds_barrier();
    } else if (ntile >= 6 && ntile <= 9) {
      const float sc = (ntile < 8) ? (0.125f * 1.4426950408889634f) : 1.0f;
      const float4* rope = reinterpret_cast<const float4*>(p.ws + OFF_ROPE);
      float4 rt[2][4][2];
#pragma unroll
      for (int ai = 0; ai < 2; ++ai)
#pragma unroll
        for (int m = 0; m < 4; ++m) {
          const int row = brow + ai * 128 + wr * 64 + m * 16 + fr;
          const float4* tb = rope + ((size_t)row * 32 + (wc & 1) * 16 + fq * 4) / 2;
          rt[ai][m][0] = tb[0]; rt[ai][m][1] = tb[1];
        }
      SCHED;
#pragma unroll
      for (int ai = 0; ai < 2; ++ai)
#pragma unroll
        for (int m = 0; m < 4; ++m) {
          const int row = brow + ai * 128 + wr * 64 + m * 16 + fr;
          const float4 cs0 = rt[ai][m][0], cs1 = rt[ai][m][1];
          const float c[4] = {cs0.x, cs0.z, cs1.x, cs1.z};
          const float s[4] = {cs0.y, cs0.w, cs1.y, cs1.w};
#pragma unroll
          for (int bj = 0; bj < 2; ++bj) {
            const f32x4 x1 = acc[ai][bj][m][0], x2 = acc[ai][bj][m][1];
            float o1[4], o2[4];
#pragma unroll
            for (int j = 0; j < 4; ++j) {
              o1[j] = (x1[j] * c[j] - x2[j] * s[j]) * sc;
              o2[j] = (x2[j] * c[j] + x1[j] * s[j]) * sc;
            }
            const int col = bcol + bj * 128 + wc * 32 + fq * 8;
            *reinterpret_cast<uint4*>(zb + (size_t)row * NIN + col) = pack8(o1, o2);
          }
        }
    } else if (ntile < 2) {
      const float* bcum = reinterpret_cast<const float*>(p.ws + OFF_BCUM);
      u16* kdt = ws16 + OFF_KDT / 2;
      u16* Tt = reinterpret_cast<u16*>(smem);
      lds_barrier();
#pragma unroll
      for (int ai = 0; ai < 2; ++ai) {
        float4 bq4[4][2][2], lq4[2][2];
        SCHED;
#pragma unroll
        for (int bj = 0; bj < 2; ++bj)
#pragma unroll
          for (int n = 0; n < 2; ++n) {
            const int cg = bj * 128 + wc * 32 + fq * 8 + n * 4;
            lq4[bj][n] = *reinterpret_cast<const float4*>(bcum + (size_t)((brow + ai * 128 + wr * 64) | 63) * 256 + cg);
#pragma unroll
            for (int m = 0; m < 4; ++m)
              bq4[m][bj][n] = *reinterpret_cast<const float4*>(bcum + (size_t)(brow + ai * 128 + wr * 64 + m * 16 + fr) * 256 + cg);
          }
        SCHED;
#pragma unroll
        for (int m = 0; m < 4; ++m) {
          const int row = brow + ai * 128 + wr * 64 + m * 16 + fr;
#pragma unroll
          for (int bj = 0; bj < 2; ++bj) {
            float f[2][4], g[2][4];
#pragma unroll
            for (int n = 0; n < 2; ++n) {
              const int cg = bj * 128 + wc * 32 + fq * 8 + n * 4;
              const float4 b4 = bq4[m][bj][n];
              const float bb[4] = {b4.x, b4.y, b4.z, b4.w};
              const f32x4 v = acc[ai][bj][m][n];
              if (ntile == 0) {
#pragma unroll
                for (int j = 0; j < 4; ++j) { const float q = v[j] * 0.125f; f[n][j] = q * __expf(bb[j]); g[n][j] = q * __expf(-bb[j]); }
              } else {
                const float4 l4 = lq4[bj][n];
                const float bl[4] = {l4.x, l4.y, l4.z, l4.w};
#pragma unroll
                for (int j = 0; j < 4; ++j) { f[n][j] = v[j] * __expf(bb[j]); g[n][j] = v[j] * __expf(-bb[j]); }
                const int tl = ai * 128 + wr * 64 + m * 16 + fr;
#pragma unroll
                for (int j = 0; j < 4; ++j) Tt[(cg + j) * 264 + tl] = f2bf(v[j] * __expf(bl[j] - bb[j]));
              }
            }
            const int c8 = bj * 128 + wc * 32 + fq * 8;
            const int o1 = (ntile == 0) ? 0 : 256, o2 = (ntile == 0) ? 512 : 768;
            *reinterpret_cast<uint4*>(zb + (size_t)row * NIN + o1 + c8) = pack8(f[0], f[1]);
            *reinterpret_cast<uint4*>(zb + (size_t)row * NIN + o2 + c8) = pack8(g[0], g[1]);
          }
        }
      }
      lds_barrier();
      if (ntile == 1) {
        const int bq = brow >> 12, t0 = brow & 4095;
#pragma unroll 4
        for (int i = 0; i < 16; ++i) {
          const int L = i * 512 + tidE, c = L >> 5, ch = L & 31;
          const bf16x8 v = *reinterpret_cast<const bf16x8*>(Tt + c * 264 + ch * 8);
          *reinterpret_cast<bf16x8*>(kdt + ((size_t)((bq * 4 + (c >> 6)) * 64 + (c & 63))) * 4096 + t0 + ch * 8) = v;
        }
      }
      lds_barrier();
    } else {
#pragma unroll
      for (int ai = 0; ai < 2; ++ai)
#pragma unroll
        for (int m = 0; m < 4; ++m) {
          SCHED; const int row = brow + ai * 128 + wr * 64 + m * 16 + fr;
#pragma unroll
          for (int bj = 0; bj < 2; ++bj) {
            float sg[2][4];
#pragma unroll
            for (int n = 0; n < 2; ++n) {
              const f32x4 v = acc[ai][bj][m][n];
#pragma unroll
              for (int j = 0; j < 4; ++j) sg[n][j] = v[j] * __builtin_amdgcn_rcpf(1.0f + __expf(-v[j]));
            }
            *reinterpret_cast<uint4*>(zb + (size_t)row * NIN + bcol + bj * 128 + wc * 32 + fq * 8) = pack8(sg[0], sg[1]);
          }
        }
    }
  } else if constexpr (EPI == EPI_RES) {
    u16* hb = ws16 + OFF_U0 / 2;
    const int wvE = tidE >> 6, lnE = tidE & 63;
#pragma unroll
    for (int ai = 0; ai < 2; ++ai)
#pragma unroll
      for (int m = 0; m < 4; ++m) {
        SCHED;
        float* F = reinterpret_cast<float*>(smem + ((m & 1) ? 98304 : 32768));
        float4 xr[4];
#pragma unroll
        for (int rr = 0; rr < 4; ++rr) {
          const int rl = wvE * 4 + rr;
          const int grow = brow + ai * 128 + (rl >> 4) * 64 + m * 16 + (rl & 15);
          xr[rr] = *reinterpret_cast<const float4*>(ea.res + (size_t)grow * DM + bcol + lnE * 4);
        }
#pragma unroll
        for (int bj = 0; bj < 2; ++bj)
#pragma unroll
          for (int n = 0; n < 2; ++n) {
            const int chunk = (bj * 128 + wc * 32 + fq * 8 + n * 4) >> 2;
            *reinterpret_cast<f32x4*>(F + (wr * 16 + fr) * 256 + ((chunk ^ fr) << 2)) = acc[ai][bj][m][n];
          }
        lds_barrier();
#pragma unroll
        for (int rr = 0; rr < 4; ++rr) {
          const int rl = wvE * 4 + rr;
          const int grow = brow + ai * 128 + (rl >> 4) * 64 + m * 16 + (rl & 15);
          const float4 v = *reinterpret_cast<const float4*>(F + rl * 256 + ((lnE ^ (rl & 15)) << 2));
          const float h0 = xr[rr].x + v.x, h1 = xr[rr].y + v.y, h2 = xr[rr].z + v.z, h3 = xr[rr].w + v.w;
          *reinterpret_cast<float4*>(p.out + (size_t)grow * DM + bcol + lnE * 4) = make_float4(h0, h1, h2, h3);
          *reinterpret_cast<s16x4*>(hb + (size_t)grow * DM + bcol + lnE * 4) = pack4(h0, h1, h2, h3);
          float ss = h0 * h0 + h1 * h1 + h2 * h2 + h3 * h3;
          ss += __shfl_xor(ss, 1); ss += __shfl_xor(ss, 2); ss += __shfl_xor(ss, 4); ss += __shfl_xor(ss, 8);
          ss = xor16_sum(ss);
          ss = xor32_sum(ss);
          if (lnE == 0) ea.ssq_out[(size_t)grow * 4 + (bcol >> 8)] = ss;
        }
      }
    lds_barrier();
  } else if constexpr (EPI == EPI_NONE) {
    float sm = 0.f;
#pragma unroll
    for (int ai = 0; ai < 2; ++ai)
#pragma unroll
      for (int bj = 0; bj < 2; ++bj)
#pragma unroll
        for (int m = 0; m < 4; ++m)
#pragma unroll
          for (int n = 0; n < 2; ++n) sm += acc[ai][bj][m][n][0] + acc[ai][bj][m][n][1] + acc[ai][bj][m][n][2] + acc[ai][bj][m][n][3];
    if (sm == 1.2345e30f) reinterpret_cast<float*>(p.ws + OFF_HALO)[tidE] = sm;
  } else if constexpr (EPI == EPI_PP) {
    u16* pp = ws16 + OFF_OB / 2;
#pragma unroll
    for (int ai = 0; ai < 2; ++ai)
#pragma unroll
      for (int m = 0; m < 4; ++m) {
        SCHED; const int row = brow + ai * 128 + wr * 64 + m * 16 + fr;
#pragma unroll
        for (int bj = 0; bj < 2; ++bj)
#pragma unroll
          for (int n = 0; n < 2; n += 2) {
            const int col = bcol + bj * 128 + wc * 32 + fq * 8;
            const f32x4 v0 = acc[ai][bj][m][0], v1 = acc[ai][bj][m][1];
            const float a0[4] = {v0[0], v0[1], v0[2], v0[3]}, a1[4] = {v1[0], v1[1], v1[2], v1[3]};
            *reinterpret_cast<uint4*>(pp + (size_t)row * DM + col) = pack8(a0, a1);
          }
      }
  } else if constexpr (EPI == EPI_PLE) {
    const u16* pp = ws16 + OFF_OB / 2;
    unsigned long long* slots = reinterpret_cast<unsigned long long*>(p.ws + OFF_SLOT);
    constexpr bool fused = FUSED;
#pragma unroll
    for (int ai = 0; ai < 2; ++ai)
#pragma unroll
      for (int m = 0; m < 4; ++m) {
        SCHED; const int row = brow + ai * 128 + wr * 64 + m * 16 + fr;
        const float r2 = rs4(ea.ssq_in, row);
        float ss = 0.f;
#pragma unroll
        for (int bj = 0; bj < 2; ++bj)
#pragma unroll
          for (int n = 0; n < 2; ++n) {
            const int col = bcol + bj * 128 + wc * 32 + fq * 8 + n * 4;
            const float4 hr = *reinterpret_cast<const float4*>(p.out + (size_t)row * DM + col);
            const s16x4 pv = *reinterpret_cast<const s16x4*>(pp + (size_t)row * DM + col);
            const f32x4 v = acc[ai][bj][m][n];
            float h[4] = {hr.x, hr.y, hr.z, hr.w};
#pragma unroll
            for (int j = 0; j < 4; ++j) {
              const float g = __builtin_amdgcn_rcpf(1.0f + __expf(-v[j] * r2));
              h[j] += g * bf2f((u16)pv[j]);
              ss += h[j] * h[j];
            }
            acc[ai][bj][m][n] = f32x4{h[0], h[1], h[2], h[3]};
            if (!fused) *reinterpret_cast<float4*>(p.out + (size_t)row * DM + col) = make_float4(h[0], h[1], h[2], h[3]);
          }
        ss = xor16_sum(ss);
        ss = xor32_sum(ss);
        if (fq == 0) {
          if (fused) {
            const unsigned long long pk = ((unsigned long long)1u << 32) | (unsigned long long)__float_as_uint(ss);
            __hip_atomic_store(slots + (size_t)row * 16 + (bcol >> 8) * 4 + wc, pk, __ATOMIC_RELAXED, __HIP_MEMORY_SCOPE_AGENT);
          } else {
            ea.ssq_out[(size_t)row * 16 + (bcol >> 8) * 4 + wc] = ss;
          }
        }
      }
    SCHED;
    float4 gfin[2][2];
#pragma unroll
    for (int bj = 0; bj < 2; ++bj)
#pragma unroll
      for (int n = 0; n < 2; ++n) gfin[bj][n] = *reinterpret_cast<const float4*>(p.norm_final + bcol + bj * 128 + wc * 32 + fq * 8 + n * 4);
    if (fused)
#pragma unroll
    for (int ai = 0; ai < 2; ++ai)
#pragma unroll
      for (int m = 0; m < 4; ++m) {
        SCHED; const int row = brow + ai * 128 + wr * 64 + m * 16 + fr;
        float part = 0.f;
#pragma unroll
        for (int k = 0; k < 4; ++k) {
          unsigned long long* sp = slots + (size_t)row * 16 + fq * 4 + k;
          unsigned long long vv = __hip_atomic_load(sp, __ATOMIC_RELAXED, __HIP_MEMORY_SCOPE_AGENT);
          unsigned spins = 0;
          while ((unsigned)(vv >> 32) != 1u && ++spins < (1u << 22)) {
            __builtin_amdgcn_s_sleep(1);
            vv = __hip_atomic_load(sp, __ATOMIC_RELAXED, __HIP_MEMORY_SCOPE_AGENT);
          }
          part += __uint_as_float((unsigned)vv);
        }
        part = xor16_sum(part);
        part = xor32_sum(part);
        const float r3 = rsqrtf(part * (1.0f / 1024.0f) + EPS);
#pragma unroll
        for (int bj = 0; bj < 2; ++bj)
#pragma unroll
          for (int n = 0; n < 2; ++n) {
            const int col = bcol + bj * 128 + wc * 32 + fq * 8 + n * 4;
            const float4 g4 = gfin[bj][n];
            const f32x4 h = acc[ai][bj][m][n];
            __builtin_nontemporal_store(f32x4{h[0] * r3 * g4.x, h[1] * r3 * g4.y, h[2] * r3 * g4.z, h[3] * r3 * g4.w},
                                        reinterpret_cast<f32x4*>(p.out + (size_t)row * DM + col));
          }
      }
  } else if constexpr (EPI == EPI_UP) {
    float* T = reinterpret_cast<float*>(smem);
    float* Hh = T + 128 * 260;
    float* halo = reinterpret_cast<float*>(p.ws + OFF_HALO);
    u16* ab = ws16 + OFF_ZB / 2;
    const int ntile = bcol >> 8, mtile = brow >> 8;
    const int tid = tidE;
    const int c4 = (tid & 31) * 4;
    const int f = ntile * 128 + c4;
    float r1v[2][4];
#pragma unroll
    for (int ai = 0; ai < 2; ++ai)
#pragma unroll
      for (int m = 0; m < 4; ++m) r1v[ai][m] = rs4(ea.ssq_in, brow + ai * 128 + wr * 64 + m * 16 + fr);
    SCHED;
#pragma unroll
    for (int ai = 0; ai < 2; ++ai) {
      lds_barrier();
#pragma unroll
      for (int m = 0; m < 4; ++m) {
        const int rl = wr * 64 + m * 16 + fr;
        const float r1 = r1v[ai][m];
#pragma unroll
        for (int bj = 0; bj < 2; ++bj)
#pragma unroll
          for (int n = 0; n < 2; ++n) {
            const int cl = bj * 128 + wc * 32 + fq * 8 + n * 4;
            const f32x4 v = acc[ai][bj][m][n];
            *reinterpret_cast<float4*>(T + rl * 260 + cl) = make_float4(v[0] * r1, v[1] * r1, v[2] * r1, v[3] * r1);
          }
      }
      lds_barrier();
      SCHED;
      float4 wg[3], wv[3];
#pragma unroll
      for (int j = 0; j < 3; ++j) {
        wg[j] = *reinterpret_cast<const float4*>(p.conv_w + (size_t)j * NUP + f);
        wv[j] = *reinterpret_cast<const float4*>(p.conv_w + (size_t)j * NUP + NFF + f);
      }
      const float4 bg = *reinterpret_cast<const float4*>(p.conv_b + f);
      const float4 bv = *reinterpret_cast<const float4*>(p.conv_b + NFF + f);
#pragma unroll 1
      for (int i = 0; i < 8; ++i) {
        const int rl = (tid >> 5) + 16 * i;
        const int row = brow + ai * 128 + rl;
        const float4 u2g = *reinterpret_cast<const float4*>(T + rl * 260 + c4);
        const float4 u2v = *reinterpret_cast<const float4*>(T + rl * 260 + 128 + c4);
        if (ai == 0 && rl < 2) {
          float* hd = halo + ((size_t)(mtile * 4 + rl)) * NUP + ntile * 256 + c4;
          *reinterpret_cast<float4*>(hd) = u2g;
          *reinterpret_cast<float4*>(hd + 128) = u2v;
          continue;
        }
        if (ai == 1 && rl >= 126) {
          float* hd = halo + ((size_t)(mtile * 4 + 2 + (rl - 126))) * NUP + ntile * 256 + c4;
          *reinterpret_cast<float4*>(hd) = u2g;
          *reinterpret_cast<float4*>(hd + 128) = u2v;
        }
        if (ai == 0 && rl >= 126) {
          *reinterpret_cast<float4*>(Hh + (rl - 126) * 256 + c4) = u2g;
          *reinterpret_cast<float4*>(Hh + (rl - 126) * 256 + 128 + c4) = u2v;
        }
        const float* p1 = (rl >= 1) ? (T + (rl - 1) * 260) : (Hh + 256);
        const float* p0 = (rl >= 2) ? (T + (rl - 2) * 260) : (Hh + rl * 256);
        const float4 u1g = *reinterpret_cast<const float4*>(p1 + c4);
        const float4 u1v = *reinterpret_cast<const float4*>(p1 + 128 + c4);
        const float4 u0g = *reinterpret_cast<const float4*>(p0 + c4);
        const float4 u0v = *reinterpret_cast<const float4*>(p0 + 128 + c4);
        const float cg0 = bg.x + wg[0].x * u0g.x + wg[1].x * u1g.x + wg[2].x * u2g.x;
        const float cg1 = bg.y + wg[0].y * u0g.y + wg[1].y * u1g.y + wg[2].y * u2g.y;
        const float cg2 = bg.z + wg[0].z * u0g.z + wg[1].z * u1g.z + wg[2].z * u2g.z;
        const float cg3 = bg.w + wg[0].w * u0g.w + wg[1].w * u1g.w + wg[2].w * u2g.w;
        const float cv0 = bv.x + wv[0].x * u0v.x + wv[1].x * u1v.x + wv[2].x * u2v.x;
        const float cv1 = bv.y + wv[0].y * u0v.y + wv[1].y * u1v.y + wv[2].y * u2v.y;
        const float cv2 = bv.z + wv[0].z * u0v.z + wv[1].z * u1v.z + wv[2].z * u2v.z;
        const float cv3 = bv.w + wv[0].w * u0v.w + wv[1].w * u1v.w + wv[2].w * u2v.w;
        *reinterpret_cast<s16x4*>(ab + (size_t)row * NFF + f) =
            pack4(gelu_tanh(cg0) * cv0, gelu_tanh(cg1) * cv1, gelu_tanh(cg2) * cv2, gelu_tanh(cg3) * cv3);
      }
    }
    lds_barrier();
  }
}

DI void tile_map(int t, int nM, int nN, int& pm, int& pn) {
  const int nwg = nM * nN;
  const int q = nwg / 8, r = nwg % 8, xcd = t % 8, off = t / 8;
  int w = (xcd < r ? xcd * (q + 1) : r * (q + 1) + (xcd - r) * q) + off;
  const int nig = 8 * nN, gid = w / nig, fm = gid * 8;
  const int gsz = min(nM - fm, 8);
  pm = fm + ((w % nig) % gsz);
  pn = (w % nig) / gsz;
}

DI f32x4 mma16(const u16* A, int lda, const u16* B, int ldb, int K, f32x4 acc, int fr, int fq) {
  for (int k0 = 0; k0 < K; k0 += 32) {
    const bf16x8 a = *reinterpret_cast<const bf16x8*>(A + fr * lda + k0 + fq * 8);
    const bf16x8 b = *reinterpret_cast<const bf16x8*>(B + fr * ldb + k0 + fq * 8);
    acc = __builtin_amdgcn_mfma_f32_16x16x32_bf16(a, b, acc, 0, 0, 0);
  }
  return acc;
}


__device__ void gla_chain(const Params& p, const int wv, const int b, const int h) {
  const int tid = tid_fresh(wv), w = tid >> 6, lane = tid & 63, fr = lane & 15, fq = lane >> 4;
  u16* ws16 = reinterpret_cast<u16*>(p.ws);
  const u16* zb = ws16 + OFF_ZB / 2;
  const u16* vtg = ws16 + OFF_VTG / 2 + (size_t)((b * 4 + h) * 128) * 4096;
  const u16* kdtg = ws16 + OFF_KDT / 2 + (size_t)((b * 4 + h) * 64) * 4096;
  const float* bcum = reinterpret_cast<const float*>(p.ws + OFF_BCUM);
  u16* ob = ws16 + OFF_OB / 2;
  constexpr int LD = 72;
  float* DEC = reinterpret_cast<float*>(smem);
  u16* QF  = reinterpret_cast<u16*>(smem + 16640);
  u16* QN  = reinterpret_cast<u16*>(smem + 25856);
  u16* KF  = reinterpret_cast<u16*>(smem + 35072);
  u16* KN  = reinterpret_cast<u16*>(smem + 44288);
  u16* KDT = reinterpret_cast<u16*>(smem + 53504);
  u16* AM  = reinterpret_cast<u16*>(smem + 62720);
  u16* VT  = reinterpret_cast<u16*>(smem + 71936);
  u16* ST  = reinterpret_cast<u16*>(smem + 90368);
  float* SSQ  = reinterpret_cast<float*>(smem + 119296);
  float* RN   = reinterpret_cast<float*>(smem + 121344);

  __syncthreads();
  for (int e = tid; e < 128 * LD; e += 512) ST[e] = 0;
  f32x4 sacc[4];
#pragma unroll
  for (int i = 0; i < 4; ++i) sacc[i] = f32x4{0.f, 0.f, 0.f, 0.f};
  const int t_ = tid >> 3, d8 = (tid & 7) * 8;
  const float gnrm = p.gla_norm[h * 128 + w * 16 + fr];
  __syncthreads();

  bf16x8 qfn, qnn, kfn, knn, kdn, vtn[2];
  float decn = 0.f;
  u16 gn16[16];
#define GLA_LOAD(nn) do { \
    const int tb_ = b * 4096 + (nn) * 64; \
    const u16* zr_ = zb + (size_t)(tb_ + t_) * NIN + h * 64 + d8; \
    qfn = *reinterpret_cast<const bf16x8*>(zr_); \
    kfn = *reinterpret_cast<const bf16x8*>(zr_ + 256); \
    qnn = *reinterpret_cast<const bf16x8*>(zr_ + 512); \
    knn = *reinterpret_cast<const bf16x8*>(zr_ + 768); \
    kdn = *reinterpret_cast<const bf16x8*>(kdtg + (size_t)t_ * 4096 + (nn) * 64 + d8); \
    if (tid < 64) decn = bcum[(size_t)(tb_ + 63) * 256 + h * 64 + tid]; \
    _Pragma("unroll") for (int i_ = 0; i_ < 2; ++i_) { const int L_ = i_ * 512 + tid, dv_ = L_ >> 3, c_ = L_ & 7; \
      vtn[i_] = *reinterpret_cast<const bf16x8*>(vtg + (size_t)dv_ * 4096 + (nn) * 64 + c_ * 8); } \
    _Pragma("unroll") for (int tb2_ = 0; tb2_ < 4; ++tb2_) _Pragma("unroll") for (int j_ = 0; j_ < 4; ++j_) \
      gn16[tb2_ * 4 + j_] = zb[(size_t)(tb_ + tb2_ * 16 + fq * 4 + j_) * NIN + 1024 + h * 128 + w * 16 + fr]; \
  } while (0)
  GLA_LOAD(0);
#pragma unroll 1
  for (int n = 0; n < 64; ++n) {
    const int tokb = b * 4096 + n * 64;
    u16 g16[16];
#pragma unroll
    for (int i = 0; i < 16; ++i) g16[i] = gn16[i];
    *reinterpret_cast<bf16x8*>(QF + t_ * LD + d8) = qfn;
    *reinterpret_cast<bf16x8*>(QN + t_ * LD + d8) = qnn;
    *reinterpret_cast<bf16x8*>(KF + t_ * LD + d8) = kfn;
    *reinterpret_cast<bf16x8*>(KN + t_ * LD + d8) = knn;
    *reinterpret_cast<bf16x8*>(KDT + t_ * LD + d8) = kdn;
    if (tid < 64) DEC[tid] = __expf(decn);
#pragma unroll
    for (int i = 0; i < 2; ++i) {
      const int L = i * 512 + tid, dv = L >> 3, c = L & 7;
      *reinterpret_cast<bf16x8*>(VT + dv * LD + c * 8) = vtn[i];
    }
    if (n + 1 < 64) GLA_LOAD(n + 1);
    lds_barrier();
#pragma unroll
    for (int bi2 = 0; bi2 < 2; ++bi2) {
      const int bi = w * 2 + bi2, ti = bi >> 2, si = bi & 3;
      const f32x4 z4 = f32x4{0.f, 0.f, 0.f, 0.f};
      const f32x4 fw = mma16(QF + ti * 16 * LD, LD, KN + si * 16 * LD, LD, 64, z4, fr, fq);
      const f32x4 bw = mma16(QN + ti * 16 * LD, LD, KF + si * 16 * LD, LD, 64, z4, fr, fq);
#pragma unroll
      for (int j = 0; j < 4; ++j) {
        const int t = ti * 16 + fq * 4 + j, s = si * 16 + fr;
        AM[t * LD + s] = f2bf((s <= t) ? fw[j] : bw[j]);
      }
    }
    lds_barrier();
    f32x4 oacc[4];
#pragma unroll
    for (int tb = 0; tb < 4; ++tb) {
      f32x4 a = f32x4{0.f, 0.f, 0.f, 0.f};
      a = mma16(AM + tb * 16 * LD, LD, VT + w * 16 * LD, LD, 64, a, fr, fq);
      a = mma16(QF + tb * 16 * LD, LD, ST + w * 16 * LD, LD, 64, a, fr, fq);
      oacc[tb] = a;
#pragma unroll
      for (int j = 0; j < 4; ++j) {
        float v = a[j] * a[j];
        v += __shfl_xor(v, 1); v += __shfl_xor(v, 2); v += __shfl_xor(v, 4); v += __shfl_xor(v, 8);
        if (fr == 0) SSQ[(tb * 16 + fq * 4 + j) * 8 + w] = v;
      }
    }
    lds_barrier();
    if (tid < 64) {
      const float4 s0 = *reinterpret_cast<const float4*>(SSQ + tid * 8), s1 = *reinterpret_cast<const float4*>(SSQ + tid * 8 + 4);
      const float tot = (s0.x + s0.y + s0.z + s0.w) + (s1.x + s1.y + s1.z + s1.w);
      RN[tid] = rsqrtf(tot * (1.0f / 128.0f) + EPS);
    }
#pragma unroll
    for (int db = 0; db < 4; ++db) {
      const float dec = DEC[db * 16 + fr];
      f32x4 a = sacc[db];
#pragma unroll
      for (int j = 0; j < 4; ++j) a[j] *= dec;
      a = mma16(VT + w * 16 * LD, LD, KDT + db * 16 * LD, LD, 64, a, fr, fq);
      sacc[db] = a;
#pragma unroll
      for (int j = 0; j < 4; ++j) ST[(w * 16 + fq * 4 + j) * LD + db * 16 + fr] = f2bf(a[j]);
    }
    lds_barrier();
    {
      const int dv = w * 16 + fr;
#pragma unroll
      for (int tb = 0; tb < 4; ++tb) {
        const float4 rn4 = *reinterpret_cast<const float4*>(RN + tb * 16 + fq * 4);
        const float rn[4] = {rn4.x, rn4.y, rn4.z, rn4.w};
#pragma unroll
        for (int j = 0; j < 4; ++j) {
          const int t = tb * 16 + fq * 4 + j;
          ob[(size_t)(tokb + t) * DM + h * 128 + dv] = f2bf(oacc[tb][j] * rn[j] * gnrm * bf2f(g16[tb * 4 + j]));
        }
      }
    }
  }
}
#undef GLA_LOAD

DI int kperm(int r) { return (r & ~12) | ((r & 4) << 1) | ((r & 8) >> 1); }

__device__ void attn_item(const Params& p, const int wv, const int b, const int h, const int qt) {
  f32x16 o[4];
  float lsum = 0.f;
  {
  const int tid = tid_fresh(wv), w = tid >> 6, lane = tid & 63, lr = lane & 31, lh = lane >> 5;
  const int mp = w >> 2, wq = w & 3;
  u16* ws16 = reinterpret_cast<u16*>(p.ws);
  const u16* zb = ws16 + OFF_ZB / 2;
  const u16* kg = zb + (size_t)(b * 4096) * NIN + 2048 + h * 128;
  const u16* vg = ws16 + OFF_VTD / 2 + (size_t)((b * 4 + h) * 128) * 4096;
  const int tok = b * 4096 + qt * 128 + wq * 32 + lr;
  const int nkt_all = qt * 2 + 2;
  const int my_nkt = qt * 2 + (wq >> 1) + 1;

  bf16x8 qf[4];
#pragma unroll
  for (int ks = 0; ks < 4; ++ks)
    qf[ks] = *reinterpret_cast<const bf16x8*>(zb + (size_t)tok * NIN + 1536 + h * 128 + mp * 64 + ks * 16 + lh * 8);
#pragma unroll
  for (int bl = 0; bl < 4; ++bl)
#pragma unroll
    for (int i = 0; i < 16; ++i) o[bl][i] = 0.f;
  float mrun = 0.f;

  const u16* kp0; const u16* kp1; const u16* vp0; const u16* vp1;
  {
    const int L0 = tid, L1 = 512 + tid;
    kp0 = kg + (size_t)(L0 >> 4) * NIN + (((L0 & 15) ^ ((L0 >> 4) & 15)) * 8);
    kp1 = kg + (size_t)(L1 >> 4) * NIN + (((L1 & 15) ^ ((L1 >> 4) & 15)) * 8);
    vp0 = vg + (size_t)(L0 >> 3) * 4096 + (((L0 & 7) ^ ((L0 >> 4) & 7)) * 8);
    vp1 = vg + (size_t)(L1 >> 3) * 4096 + (((L1 & 7) ^ ((L1 >> 4) & 7)) * 8);
  }
#define ASTAGE(kt, buf) do { \
    __builtin_amdgcn_global_load_lds((const unsigned*)kp0, (unsigned*)(smem + (buf) * 16384 + tid * 16), 16, 0, 0); \
    __builtin_amdgcn_global_load_lds((const unsigned*)vp0, (unsigned*)(smem + 65536 + (buf) * 16384 + tid * 16), 16, 0, 0); \
    __builtin_amdgcn_global_load_lds((const unsigned*)kp1, (unsigned*)(smem + (buf) * 16384 + 8192 + tid * 16), 16, 0, 0); \
    __builtin_amdgcn_global_load_lds((const unsigned*)vp1, (unsigned*)(smem + 65536 + (buf) * 16384 + 8192 + tid * 16), 16, 0, 0); \
    kp0 += 64 * NIN; kp1 += 64 * NIN; vp0 += 64; vp1 += 64; \
  } while (0)

  constexpr bool late = false;
  const int koff0 = kperm(lr) * 256, kx = kperm(lr) & 15;
#define PV_STEP(VOFF) do { \
    _Pragma("unroll") for (int hb = 0; hb < 4; ++hb) { \
      bf16x8 vfr[4]; \
      _Pragma("unroll") for (int q_ = 0; q_ < 4; ++q_) { \
        const int bl = hb, s4 = q_, dvrow = bl * 32 + lr; \
        const int c = s4 * 2 + lh, ph = c ^ ((dvrow >> 1) & 7); \
        vfr[q_] = *reinterpret_cast<const bf16x8*>(smem + (VOFF) + dvrow * 128 + ph * 16); } \
      __builtin_amdgcn_sched_barrier(0); \
      _Pragma("unroll") for (int q_ = 0; q_ < 4; ++q_) { \
        const int bl = hb, s4 = q_; \
        o[bl] = __builtin_amdgcn_mfma_f32_32x32x16_bf16(vfr[q_], pf[s4], o[bl], 0, 0, 0); } \
      __builtin_amdgcn_sched_barrier(0); \
    } } while (0)
#define ATT_ITER(J) do { \
    const int kt = kt0 + (J); \
    if (kt + 1 < nkt_all) asm volatile("s_waitcnt vmcnt(4)" ::: "memory"); \
    else asm volatile("s_waitcnt vmcnt(0)" ::: "memory"); \
    __builtin_amdgcn_s_barrier(); \
    asm volatile("" ::: "memory"); \
    if (kt + 2 < nkt_all) ASTAGE(kt + 2, ((J) + 2) & 3); \
    if (late && kt >= 1 && kt - 1 < my_nkt) PV_STEP(65536 + (((J) + 3) & 3) * 16384); \
    if (kt < my_nkt) { \
      bf16x8 kfr[8]; \
      _Pragma("unroll") for (int q_ = 0; q_ < 8; ++q_) { \
        const int kb = q_ >> 2, ks = q_ & 3; \
        const int cc = mp * 8 + ks * 2 + lh, ph = cc ^ kx; \
        kfr[q_] = *reinterpret_cast<const bf16x8*>(smem + (J) * 16384 + kb * 8192 + koff0 + ph * 16); } \
      __builtin_amdgcn_sched_barrier(0); \
      f32x16 s[2]; \
      const float ninit = -mrun; \
      _Pragma("unroll") for (int kb = 0; kb < 2; ++kb) { \
        _Pragma("unroll") for (int i = 0; i < 16; ++i) s[kb][i] = ninit; \
        _Pragma("unroll") for (int ks = 0; ks < 4; ++ks) \
          s[kb] = __builtin_amdgcn_mfma_f32_32x32x16_bf16(kfr[kb * 4 + ks], qf[ks], s[kb], 0, 0, 0); } \
      __builtin_amdgcn_sched_barrier(0); \
      float mx = s[0][0]; \
      _Pragma("unroll") for (int i = 1; i < 16; ++i) mx = fmaxf(mx, s[0][i]); \
      _Pragma("unroll") for (int i = 0; i < 16; ++i) mx = fmaxf(mx, s[1][i]); \
      mx = xor32_max(mx); \
      if (kt == 0) { \
        mrun = mx; \
        _Pragma("unroll") for (int kb = 0; kb < 2; ++kb) _Pragma("unroll") for (int i = 0; i < 16; ++i) s[kb][i] -= mx; \
      } else if (__any(mx > 6.0f)) { \
        const float delta = fmaxf(mx, 0.f); \
        const float alpha = __builtin_amdgcn_exp2f(-delta); \
        mrun += delta; lsum *= alpha; \
        _Pragma("unroll") for (int bl = 0; bl < 4; ++bl) _Pragma("unroll") for (int i = 0; i < 16; ++i) o[bl][i] *= alpha; \
        _Pragma("unroll") for (int kb = 0; kb < 2; ++kb) _Pragma("unroll") for (int i = 0; i < 16; ++i) s[kb][i] -= delta; \
      } \
      float ls = lsum; \
      _Pragma("unroll") for (int s4 = 0; s4 < 4; ++s4) { \
        float v[8]; \
        _Pragma("unroll") for (int e = 0; e < 8; ++e) { v[e] = __builtin_amdgcn_exp2f(s[s4 >> 1][(s4 & 1) * 8 + e]); ls += v[e]; } \
        uint4 pk; \
        pk.x = pack2(v[0], v[1]); pk.y = pack2(v[2], v[3]); pk.z = pack2(v[4], v[5]); pk.w = pack2(v[6], v[7]); \
        pf[s4] = __builtin_bit_cast(bf16x8, pk); } \
      lsum = ls; \
      if (!late) PV_STEP(65536 + (J) * 16384); \
    } } while (0)
  bf16x8 pf[4];
#pragma unroll
  for (int i = 0; i < 4; ++i) pf[i] = bf16x8{0, 0, 0, 0, 0, 0, 0, 0};
  __syncthreads();
  ASTAGE(0, 0);
  if (nkt_all > 1) ASTAGE(1, 1);
#pragma unroll 1
  for (int kt0 = 0; kt0 < nkt_all; kt0 += 4) {
    ATT_ITER(0);
    ATT_ITER(1);
    if (kt0 + 2 < nkt_all) {
      ATT_ITER(2);
      ATT_ITER(3);
    }
  }
  if (late && nkt_all - 1 < my_nkt) {
    if ((nkt_all - 1) & 2) PV_STEP(65536 + 3 * 16384); else PV_STEP(65536 + 1 * 16384);
  }
#undef ATT_ITER
#undef PV_STEP
  __syncthreads();
#undef ASTAGE
  }
  const int tidZ = tid_fresh(wv);
  const int wZ = tidZ >> 6, lane = tidZ & 63, lh = lane >> 5, mp = wZ >> 2, wq = wZ & 3;
  const int tok = b * 4096 + qt * 128 + wq * 32 + (lane & 31);
  u16* ob = reinterpret_cast<u16*>(p.ws) + OFF_OB / 2;
  const float lt = xor32_sum(lsum);
  float lam = 0.2f;
  {
    float d1 = 0.f, d2 = 0.f;
    for (int i = 0; i < 64; ++i) { d1 += p.lq1[i] * p.lk1[i]; d2 += p.lq2[i] * p.lk2[i]; }
    lam += expf(d1) - expf(d2);
  }
  float* X = reinterpret_cast<float*>(smem);
  const float sc = (mp == 0) ? (1.0f / lt) : (lam / lt);
  if (mp == 1) {
#pragma unroll
    for (int bl = 0; bl < 4; ++bl)
#pragma unroll
      for (int i = 0; i < 16; ++i) X[(wq * 64 + bl * 16 + i) * 64 + lane] = o[bl][i] * sc;
  }
  __syncthreads();
  if (mp == 0) {
    float ss = 0.f;
#pragma unroll
    for (int bl = 0; bl < 4; ++bl)
#pragma unroll
      for (int i = 0; i < 16; ++i) {
        const float v = o[bl][i] * sc - X[(wq * 64 + bl * 16 + i) * 64 + lane];
        o[bl][i] = v;
        ss += v * v;
      }
    ss = xor32_sum(ss);
    const float rn = rsqrtf(ss * (1.0f / 128.0f) + EPS) * 0.8f;
#pragma unroll
    for (int bl = 0; bl < 4; ++bl)
#pragma unroll
      for (int g = 0; g < 4; ++g) {
        const int dv0 = bl * 32 + 8 * g + 4 * lh;
        const float4 gn = *reinterpret_cast<const float4*>(p.diff_norm + h * 128 + dv0);
        *reinterpret_cast<s16x4*>(ob + (size_t)tok * DM + 512 + h * 128 + dv0) =
            pack4(o[bl][g * 4 + 0] * rn * gn.x, o[bl][g * 4 + 1] * rn * gn.y,
                  o[bl][g * 4 + 2] * rn * gn.z, o[bl][g * 4 + 3] * rn * gn.w);
      }
  }
}

__device__ void phase_mix(const Params& p, const int wv, const int cidx, const int li_begin = 0, const int li_end = 8 + 256) {
  const int xcd = blockIdx.x & 7;
  int* cnt = reinterpret_cast<int*>(p.ws + OFF_CNT) + cidx * 8 + xcd;
  int* slot = reinterpret_cast<int*>(smem + SMEM_ITEM_OFF);
  while (true) {
    __syncthreads();
    if (tid_fresh(wv) == 0) *slot = atomicAdd(cnt, 1);
    __syncthreads();
    const int li = *slot + li_begin;
    if (li >= li_end) break;
    if (li < 8) { const int bh = xcd + 8 * li; gla_chain(p, wv, bh >> 2, bh & 3); }
    else {
      const int ai = li - 8, bh = xcd + 8 * (ai >> 5);
      attn_item(p, wv, bh >> 2, bh & 3, 31 - (ai & 31));
    }
  }
}

__device__ void phase_fixup(const Params& p, const int wv) {
  const float* halo = reinterpret_cast<const float*>(p.ws + OFF_HALO);
  u16* ab = reinterpret_cast<u16*>(p.ws) + OFF_ZB / 2;
  const int total = 256 * 2 * NFF;
  const int tidF = tid_fresh(wv);
  for (int e = blockIdx.x * 512 + tidF; e < total; e += gridDim.x * 512) {
    const int f = e % NFF, rl = (e / NFF) & 1, mtile = e / (2 * NFF);
    const int pc = (f >> 7) * 256 + (f & 127);
    const bool first = (mtile & 15) == 0;
    const float* hp = halo + (size_t)(mtile - 1) * 4 * NUP;
    const float* hc = halo + (size_t)mtile * 4 * NUP;
    const float ug0 = first ? 0.f : hp[2 * NUP + pc], uv0 = first ? 0.f : hp[2 * NUP + pc + 128];
    const float ug1 = first ? 0.f : hp[3 * NUP + pc], uv1 = first ? 0.f : hp[3 * NUP + pc + 128];
    const float ug2 = hc[pc], uv2 = hc[pc + 128];
    const float ug3 = hc[NUP + pc], uv3 = hc[NUP + pc + 128];
    const bool r0 = (rl == 0);
    const float a0 = r0 ? ug0 : ug1, a1 = r0 ? ug1 : ug2, a2 = r0 ? ug2 : ug3;
    const float c0 = r0 ? uv0 : uv1, c1 = r0 ? uv1 : uv2, c2 = r0 ? uv2 : uv3;
    const float cgv = p.conv_b[f] + p.conv_w[f] * a0 + p.conv_w[(size_t)NUP + f] * a1 + p.conv_w[(size_t)2 * NUP + f] * a2;
    const float cvv = p.conv_b[NFF + f] + p.conv_w[NFF + f] * c0 + p.conv_w[(size_t)NUP + NFF + f] * c1 + p.conv_w[(size_t)2 * NUP + NFF + f] * c2;
    ab[(size_t)(mtile * 256 + rl) * NFF + f] = f2bf(gelu_tanh(cgv) * cvv);
  }
}

__device__ void phase_final_rows(const Params& p, const int wv, const int row0) {
  const int tidF = tid_fresh(wv);
  const int wave = tidF >> 6, lane = tidF & 63;
  const float* ssq3 = reinterpret_cast<const float*>(p.ws + OFF_SSQ3);
#pragma unroll 1
  for (int rr = 0; rr < 32; ++rr) {
    const int row = row0 + wave * 32 + rr;
    const float r = rs_from(ssq3, row);
#pragma unroll
    for (int i = 0; i < 4; ++i) {
      float4* q = reinterpret_cast<float4*>(p.out + (size_t)row * DM + i * 256 + lane * 4);
      const float4 g = *reinterpret_cast<const float4*>(p.norm_final + i * 256 + lane * 4);
      float4 v = *q;
      v.x *= r * g.x; v.y *= r * g.y; v.z *= r * g.z; v.w *= r * g.w;
      *q = v;
    }
  }
}

__device__ void phase_final(const Params& p, const int wv) {
  const int tidF = tid_fresh(wv);
  const int wave = tidF >> 6, lane = tidF & 63;
  const float* ssq3 = reinterpret_cast<const float*>(p.ws + OFF_SSQ3);
  for (int row = blockIdx.x * 8 + wave; row < NTOK; row += gridDim.x * 8) {
    const float r = rs_from(ssq3, row);
#pragma unroll
    for (int i = 0; i < 4; ++i) {
      float4* q = reinterpret_cast<float4*>(p.out + (size_t)row * DM + i * 256 + lane * 4);
      const float4 g = *reinterpret_cast<const float4*>(p.norm_final + i * 256 + lane * 4);
      float4 v = *q;
      v.x *= r * g.x; v.y *= r * g.y; v.z *= r * g.z; v.w *= r * g.w;
      *q = v;
    }
  }
}

template <int EPI, bool FUSED = true>
__device__ __forceinline__ void gemm_phase(const Params& p, const int wv, const u16* A, const u16* Bt, int K, int nN, const EpiArgs& ea,
                                           int tile_begin, int tile_count) {
  constexpr bool kPrefetch = (EPI != EPI_UP) && (EPI != EPI_IN);
  bool pro = false;
  for (int t = blockIdx.x; t < tile_count; t += gridDim.x) {
    int pm, pn, qm = 0, qn = 0;
    tile_map(t, 256, nN, pm, pn);
    const bool nxt = kPrefetch && (t + (int)gridDim.x < tile_count);
    if (nxt) tile_map(t + gridDim.x, 256, nN, qm, qn);
    gemm_tile<EPI, FUSED>(A, Bt, K, pm * 256, pn * 256, p, ea, wv, pro, nxt, qm * 256, qn * 256);
    pro = nxt;
  }
  (void)tile_begin;
}

template <bool FUSED>
__global__ void __launch_bounds__(512) mega(Params p) {
  cg::grid_group grid = cg::this_grid();
  const int wv = __builtin_amdgcn_readfirstlane((int)(threadIdx.x >> 6));
  u16* ws16 = reinterpret_cast<u16*>(p.ws);
  float* ssq1 = reinterpret_cast<float*>(p.ws + OFF_SSQ1);
  float* ssq2 = reinterpret_cast<float*>(p.ws + OFF_SSQ2);
  float* ssq3 = reinterpret_cast<float*>(p.ws + OFF_SSQ3);

  volatile LAS unsigned* xst = (volatile LAS unsigned*)(smem + SMEM_ITEM_OFF + 128);
  if (tid_fresh(wv) < 2) xst[tid_fresh(wv)] = 0u;
  phase_prep(p, wv);
  grid.sync();
  const XcdBarrier xb = xcd_barrier_post(reinterpret_cast<unsigned*>(p.ws + OFF_XB), xst, wv);
#if PROBE_REP == 8
  xcd_barrier(xb, wv); grid.sync(); grid.sync(); grid.sync();
#endif
#if PROBE_REP == 7
  phase_prep(p, wv);
  xcd_barrier(xb, wv);
#endif
  { EpiArgs ea{nullptr, nullptr, nullptr};
    gemm_phase<EPI_IN>(p, wv, ws16 + OFF_U0 / 2, ws16 + OFF_WIN / 2, 1024, 12, ea, 0, 256 * 12); }
  xcd_barrier(xb, wv);
#if PROBE_REP == 10
  { EpiArgs ea{nullptr, nullptr, nullptr};
    gemm_phase<EPI_NONE>(p, wv, ws16 + OFF_U0 / 2, ws16 + OFF_WIN / 2, 1024, 12, ea, 0, 256 * 12); }
  xcd_barrier(xb, wv);
#endif
#if PROBE_REP == 5
  { EpiArgs ea{nullptr, nullptr, nullptr};
    gemm_phase<EPI_IN>(p, wv, ws16 + OFF_U0 / 2, ws16 + OFF_WIN / 2, 1024, 12, ea, 0, 256 * 12); }
  xcd_barrier(xb, wv);
#endif
  phase_mix(p, wv, 0);
  xcd_barrier(xb, wv);
#if PROBE_REP == 2
  phase_mix(p, wv, 1);
  xcd_barrier(xb, wv);
#endif
#if PROBE_REP == 6
  phase_mix(p, wv, 1, 8, 8 + 256);
  xcd_barrier(xb, wv);
#endif
#if PROBE_REP == 3
  phase_mix(p, wv, 1, 0, 8);
  xcd_barrier(xb, wv);
#endif
  { EpiArgs ea{p.x, ssq1, nullptr};
    gemm_phase<EPI_RES>(p, wv, ws16 + OFF_OB / 2, ws16 + OFF_WOUT / 2, 1024, 4, ea, 0, 256 * 4); }
  xcd_barrier(xb, wv);
#if PROBE_REP == 9
  { EpiArgs ea{nullptr, nullptr, ssq1};
    gemm_phase<EPI_NONE>(p, wv, ws16 + OFF_U0 / 2, ws16 + OFF_WUP / 2, 1024, 22, ea, 0, 256 * 22); }
  xcd_barrier(xb, wv);
#endif
  { EpiArgs ea{nullptr, nullptr, ssq1};
    gemm_phase<EPI_UP>(p, wv, ws16 + OFF_U0 / 2, ws16 + OFF_WUP / 2, 1024, 22, ea, 0, 256 * 22); }
  xcd_barrier(xb, wv);
#if PROBE_REP == 4
  { EpiArgs ea{nullptr, nullptr, ssq1};
    gemm_phase<EPI_UP>(p, wv, ws16 + OFF_U0 / 2, ws16 + OFF_WUP / 2, 1024, 22, ea, 0, 256 * 22); }
  xcd_barrier(xb, wv);
#endif
  phase_fixup(p, wv);
  xcd_barrier(xb, wv);
  { EpiArgs ea{p.out, ssq2, nullptr};
    gemm_phase<EPI_RES>(p, wv, ws16 + OFF_ZB / 2, ws16 + OFF_WDN / 2, 2816, 4, ea, 0, 256 * 4); }
  { EpiArgs ea{nullptr, nullptr, nullptr};
    gemm_phase<EPI_PP>(p, wv, ws16 + OFF_PB / 2, ws16 + OFF_WPP / 2, 256, 4, ea, 0, 256 * 4); }
  xcd_barrier(xb, wv);
  { EpiArgs ea{nullptr, ssq3, ssq2};
    gemm_phase<EPI_PLE, FUSED>(p, wv, ws16 + OFF_U0 / 2, ws16 + OFF_WPG / 2, 1024, 4, ea, 0, 256 * 4); }
  if constexpr (!FUSED) {
    xcd_barrier(xb, wv);
    phase_final(p, wv);
  }
}

extern "C" void kernel_launch(void* const* d_in, const int* in_sizes, int n_in, void* d_out, int out_size,
                              void* d_ws, size_t ws_size, hipStream_t stream) {
  static int grid_blocks = 0;
  static bool fused = true;
  if (!grid_blocks) {
    int dev = 0, cus = 0, per_cu = 0;
    (void)hipGetDevice(&dev);
    (void)hipDeviceGetAttribute(&cus, hipDeviceAttributeMultiprocessorCount, dev);
    (void)hipFuncSetAttribute((const void*)mega<true>, hipFuncAttributeMaxDynamicSharedMemorySize, SMEM_BYTES);
    (void)hipFuncSetAttribute((const void*)mega<false>, hipFuncAttributeMaxDynamicSharedMemorySize, SMEM_BYTES);
    (void)hipOccupancyMaxActiveBlocksPerMultiprocessor(&per_cu, mega<true>, 512, SMEM_BYTES);
    if (per_cu < 1) per_cu = 1;
    if (per_cu > 1) per_cu = 1;
    grid_blocks = cus * per_cu;
    fused = (grid_blocks == 256);
  }
  Params p{};
  p.x = (const float*)d_in[0]; p.p = (const float*)d_in[1]; p.pos = (const int*)d_in[2];
  p.norm_mix = (const float*)d_in[3]; p.w_in = (const float*)d_in[4]; p.w_a_up = (const float*)d_in[5];
  p.b_a = (const float*)d_in[6]; p.gla_norm = (const float*)d_in[7];
  p.lq1 = (const float*)d_in[8]; p.lk1 = (const float*)d_in[9]; p.lq2 = (const float*)d_in[10]; p.lk2 = (const float*)d_in[11];
  p.diff_norm = (const float*)d_in[12]; p.w_out = (const float*)d_in[13]; p.norm_ffn = (const float*)d_in[14];
  p.w_up = (const float*)d_in[15]; p.conv_w = (const float*)d_in[16]; p.conv_b = (const float*)d_in[17];
  p.w_down = (const float*)d_in[18]; p.norm_ple = (const float*)d_in[19]; p.w_pg = (const float*)d_in[20];
  p.w_pp = (const float*)d_in[21]; p.norm_final = (const float*)d_in[22];
  p.out = (float*)d_out; p.ws = (char*)d_ws;
  void* args[] = {&p};
  const void* fn = fused ? (const void*)mega<true> : (const void*)mega<false>;
  hipError_t e = hipLaunchCooperativeKernel(fn, dim3(grid_blocks), dim3(512), args, SMEM_BYTES, stream);
  if (e != hipSuccess) fprintf(stderr, "cooperative launch failed: %s (grid %d)\n", hipGetErrorString(e), grid_blocks);
}
```

```cpp
#include <hip/hip_runtime.h>
#include <hip/hip_bf16.h>
#include <hip/hip_cooperative_groups.h>
#include <cstdio>
namespace cg = cooperative_groups;

typedef unsigned short u16;
using bf16x8 = __attribute__((ext_vector_type(8))) short;
using s16x4  = __attribute__((ext_vector_type(4))) short;
using f32x4  = __attribute__((ext_vector_type(4))) float;
using f32x16 = __attribute__((ext_vector_type(16))) float;
#define DI __device__ __forceinline__
#ifndef PROBE_REP
#define PROBE_REP 0
#endif

constexpr int NTOK = 65536, DM = 1024, SEQL = 4096;
constexpr int NIN = 3072, NFF = 2816, NUP = 5632;
constexpr float EPS = 1e-6f;
constexpr int SMEM_BYTES = 139264;
constexpr int SMEM_ITEM_OFF = 139008;

constexpr size_t OFF_WIN  = 0;
constexpr size_t OFF_WOUT = OFF_WIN  + (size_t)3072 * 1024 * 2;
constexpr size_t OFF_WUP  = OFF_WOUT + (size_t)1024 * 1024 * 2;
constexpr size_t OFF_WDN  = OFF_WUP  + (size_t)5632 * 1024 * 2;
constexpr size_t OFF_WPG  = OFF_WDN  + (size_t)1024 * 2816 * 2;
constexpr size_t OFF_WPP  = OFF_WPG  + (size_t)1024 * 1024 * 2;
constexpr size_t OFF_PB   = OFF_WPP  + (size_t)1024 * 256 * 2;
constexpr size_t OFF_U0   = OFF_PB   + (size_t)NTOK * 256 * 2;
constexpr size_t OFF_ZB   = OFF_U0   + (size_t)NTOK * 1024 * 2;
constexpr size_t OFF_VTG  = OFF_ZB   + (size_t)NTOK * 3072 * 2;
constexpr size_t OFF_VTD  = OFF_VTG  + (size_t)NTOK * 512 * 2;
constexpr size_t OFF_ALOW = OFF_VTD  + (size_t)NTOK * 512 * 2;
constexpr size_t OFF_ROPE = OFF_ALOW + (size_t)NTOK * 16 * 4;
constexpr size_t OFF_OB   = OFF_ROPE + (size_t)NTOK * 32 * 8;
constexpr size_t OFF_HALO = OFF_OB   + (size_t)NTOK * 1024 * 2;
constexpr size_t OFF_SSQ1 = OFF_HALO + (size_t)256 * 4 * 5632 * 4;
constexpr size_t OFF_SSQ2 = OFF_SSQ1 + (size_t)NTOK * 16 * 4;
constexpr size_t OFF_SSQ3 = OFF_SSQ2 + (size_t)NTOK * 16 * 4;
constexpr size_t OFF_CNT  = OFF_SSQ3 + (size_t)NTOK * 16 * 4;
constexpr size_t OFF_BCUM = OFF_CNT  + 256;
constexpr size_t OFF_KDT  = OFF_BCUM + (size_t)NTOK * 256 * 4;
constexpr size_t OFF_ARR  = OFF_KDT  + (size_t)NTOK * 256 * 2;
constexpr size_t OFF_XB   = OFF_ARR  + 4096;
constexpr size_t OFF_SLOT = OFF_XB   + 16384;

struct Params {
  const float* x; const float* p; const int* pos;
  const float* norm_mix; const float* w_in; const float* w_a_up; const float* b_a; const float* gla_norm;
  const float* lq1; const float* lk1; const float* lq2; const float* lk2; const float* diff_norm;
  const float* w_out; const float* norm_ffn; const float* w_up; const float* conv_w; const float* conv_b;
  const float* w_down; const float* norm_ple; const float* w_pg; const float* w_pp; const float* norm_final;
  float* out; char* ws;
};

extern __shared__ __attribute__((aligned(16))) char smem[];

DI int tid_fresh(const int wv) {
  int l;
  asm volatile("v_mbcnt_lo_u32_b32 %0, -1, 0\n\tv_mbcnt_hi_u32_b32 %0, -1, %0" : "=v"(l));
  return wv * 64 + l;
}
typedef __bf16 bf16v2_t __attribute__((ext_vector_type(2)));
typedef float f32v2_t __attribute__((ext_vector_type(2)));
DI unsigned pack2(float a, float b) { f32v2_t v = {a, b}; return __builtin_bit_cast(unsigned, __builtin_convertvector(v, bf16v2_t)); }
DI u16 f2bf(float f) { return __builtin_bit_cast(u16, (__bf16)f); }
DI float bf2f(u16 h) { return __uint_as_float(((unsigned)h) << 16); }
DI uint4 pack8(const float* a, const float* b) {
  uint4 r; r.x = pack2(a[0], a[1]); r.y = pack2(a[2], a[3]); r.z = pack2(b[0], b[1]); r.w = pack2(b[2], b[3]); return r;
}
DI s16x4 pack4(float a, float b, float c, float d) {
  uint2 r; r.x = pack2(a, b); r.y = pack2(c, d); return __builtin_bit_cast(s16x4, r);
}
DI float xor32_sum(float x) { auto r = __builtin_amdgcn_permlane32_swap(__float_as_uint(x), __float_as_uint(x), false, false); return __uint_as_float(r[0]) + __uint_as_float(r[1]); }
DI float xor32_max(float x) { auto r = __builtin_amdgcn_permlane32_swap(__float_as_uint(x), __float_as_uint(x), false, false); return fmaxf(__uint_as_float(r[0]), __uint_as_float(r[1])); }
DI float xor16_sum(float x) { auto r = __builtin_amdgcn_permlane16_swap(__float_as_uint(x), __float_as_uint(x), false, false); return __uint_as_float(r[0]) + __uint_as_float(r[1]); }
DI void lds_barrier() { asm volatile("s_waitcnt lgkmcnt(0)" ::: "memory"); __builtin_amdgcn_s_barrier(); asm volatile("" ::: "memory"); }
DI float rs4(const float* __restrict__ ssq, int row) {
  const float4 a = *reinterpret_cast<const float4*>(ssq + (size_t)row * 4);
  return rsqrtf(((a.x + a.y) + (a.z + a.w)) * (1.0f / 1024.0f) + EPS);
}
DI float rs_from(const float* __restrict__ ssq, int row) {
  const float4* q = reinterpret_cast<const float4*>(ssq + (size_t)row * 16);
  float4 a = q[0], b = q[1], c = q[2], d = q[3];
  float s = (a.x + a.y + a.z + a.w) + (b.x + b.y + b.z + b.w) + (c.x + c.y + c.z + c.w) + (d.x + d.y + d.z + d.w);
  return rsqrtf(s * (1.0f / 1024.0f) + EPS);
}
DI float gelu_tanh(float x) {
  const float y2 = 1.5957691216057308f * (x + 0.044715f * x * x * x);
  return x * __builtin_amdgcn_rcpf(1.0f + __expf(-y2));
}


#define XB_TMO      128
#define XB_XCNT(j)  (256  + 64 * (j))
#define XB_XSUB(j)  (1280 + 64 * (j))
#define XB_XGEN(j)  (2304 + 64 * (j))
#define XB_TOP      3328
#define XB_TOPGEN   3392
#define XCD_BAR_WORDS 3456
#define XB_SPIN_CAP (1u << 18)
#define LAS __attribute__((address_space(3)))
DI unsigned xb_ld(unsigned* p)              { return __hip_atomic_load(p, __ATOMIC_RELAXED, __HIP_MEMORY_SCOPE_AGENT); }
DI unsigned xb_add(unsigned* p, unsigned v) { return __hip_atomic_fetch_add(p, v, __ATOMIC_RELAXED, __HIP_MEMORY_SCOPE_AGENT); }
DI unsigned xb_xcc_id() { return (unsigned)__builtin_amdgcn_s_getreg((3 << 11) | 20) & 0xFu; }
#define XB_SPIN(cond, bar) do { unsigned _sp = 0; while (cond) { __builtin_amdgcn_s_sleep(1); \
    if ((++_sp & 255u) == 0u) { if (xb_ld(&(bar)[XB_TMO])) break; if (_sp > XB_SPIN_CAP) { atomicAdd(&(bar)[XB_TMO], 1u); break; } } } } while (0)
struct XcdBarrier { unsigned* bar; unsigned x; volatile LAS unsigned* st; };
DI XcdBarrier xcd_barrier_post(unsigned* bar, volatile LAS unsigned* st, const int wv) {
  XcdBarrier b; b.bar = bar; b.x = xb_xcc_id(); b.st = st;
  if (tid_fresh(wv) == 0) (void)xb_add(&bar[XB_XCNT(b.x)], 1u);
  return b;
}
DI void xcd_barrier_complete(unsigned* bar, unsigned x, unsigned& nloc, unsigned& nx) {
  const unsigned G = gridDim.x * gridDim.y * gridDim.z;
  unsigned sum, cnt, mine, sp = 0u;
  for (;;) {
    sum = 0u; cnt = 0u; mine = 0u;
#pragma unroll
    for (unsigned j = 0; j < 16; ++j) { const unsigned c = xb_ld(&bar[XB_XCNT(j)]); sum += c; cnt += (c > 0u) ? 1u : 0u; mine = (j == x) ? c : mine; }
    if (sum == G) break;
    __builtin_amdgcn_s_sleep(1);
    if ((++sp & 255u) == 0u) { if (xb_ld(&bar[XB_TMO])) break; if (sp > XB_SPIN_CAP) { atomicAdd(&bar[XB_TMO], 1u); break; } }
  }
  nloc = mine > 0u ? mine : 1u; nx = cnt > 0u ? cnt : 1u;
}
DI void xcd_barrier(const XcdBarrier& b, const int wv) {
  asm volatile("s_waitcnt vmcnt(0)" ::: "memory");
  __syncthreads();
  if (tid_fresh(wv) == 0) {
    unsigned* bar = b.bar;
    __builtin_amdgcn_s_waitcnt(0);
    unsigned nloc = b.st[0], nx = b.st[1];
    if (nloc == 0u) { xcd_barrier_complete(bar, b.x, nloc, nx); b.st[0] = nloc; b.st[1] = nx; }
    const unsigned old = xb_add(&bar[XB_XSUB(b.x)], 1u);
    const unsigned gen = old / nloc;
    if (old + 1u == (gen + 1u) * nloc) {
      __builtin_amdgcn_fence(__ATOMIC_RELEASE, "agent");
      asm volatile("s_waitcnt vmcnt(0)" ::: "memory");
      const unsigned og = xb_add(&bar[XB_TOP], 1u);
      const unsigned tg = og / nx;
      if (og + 1u == (tg + 1u) * nx) xb_add(&bar[XB_TOPGEN], 1u);
      else XB_SPIN(xb_ld(&bar[XB_TOPGEN]) == tg, bar);
      __builtin_amdgcn_fence(__ATOMIC_ACQUIRE, "agent");
      xb_add(&bar[XB_XGEN(b.x)], 1u);
      asm volatile("s_waitcnt vmcnt(0)" ::: "memory");
    } else {
      XB_SPIN(xb_ld(&bar[XB_XGEN(b.x)]) == gen, bar);
      __builtin_amdgcn_fence(__ATOMIC_ACQUIRE, "agent");
      asm volatile("s_waitcnt vmcnt(0)" ::: "memory");
    }
  }
  __syncthreads();
}

DI int src_col_in(int n) {
  if (n < 1536) return n;
  if (n < 2560) {
    int g = (n - 1536) >> 6, pc = (n - 1536) & 63, s = pc >> 5, w = pc & 31;
    int d = s * 16 + (w >> 3) * 4 + (w & 3) + 32 * ((w >> 2) & 1);
    return 1552 + g * 64 + d;
  }
  return n + 16;
}
DI int src_col_up(int n) { return ((n >> 7) & 1) * 2816 + (n >> 8) * 128 + (n & 127); }

__device__ void phase_prep(const Params& p, const int wv) {
  const int tid = tid_fresh(wv);
  u16* ws16 = reinterpret_cast<u16*>(p.ws);
  if (blockIdx.x == 0 && tid < 32) reinterpret_cast<int*>(p.ws + OFF_CNT)[tid] = 0;
  if (blockIdx.x == 0) for (int e = tid; e < XCD_BAR_WORDS; e += 512) reinterpret_cast<unsigned*>(p.ws + OFF_XB)[e] = 0u;
  {
    uint4* sl = reinterpret_cast<uint4*>(p.ws + OFF_SLOT);
    for (int e = blockIdx.x * 512 + tid; e < NTOK * 16 / 2; e += gridDim.x * 512) sl[e] = make_uint4(0u, 0u, 0u, 0u);
  }
  {
    float* tl = reinterpret_cast<float*>(smem);
    const int T0 = 768, T1 = T0 + 256, T2 = T1 + 1408, T3 = T2 + 704, T4 = T3 + 256, T5 = T4 + 64;
    for (int grp = blockIdx.x; grp < T5 / 4; grp += gridDim.x) {
      float v[4][8];
      __syncthreads();
#pragma unroll
      for (int q = 0; q < 4; ++q) {
        const int tile = grp * 4 + q;
        const float* src; const float* scale = nullptr; int K, Nsrc, job, lt;
        if (tile < T0)      { job = 0; lt = tile;      src = p.w_in;   K = 1024; Nsrc = 3088; }
        else if (tile < T1) { job = 1; lt = tile - T0; src = p.w_out;  K = 1024; Nsrc = 1024; }
        else if (tile < T2) { job = 2; lt = tile - T1; src = p.w_up;   K = 1024; Nsrc = 5632; scale = p.norm_ffn; }
        else if (tile < T3) { job = 3; lt = tile - T2; src = p.w_down; K = 2816; Nsrc = 1024; }
        else if (tile < T4) { job = 4; lt = tile - T3; src = p.w_pg;   K = 1024; Nsrc = 1024; scale = p.norm_ple; }
        else                { job = 5; lt = tile - T4; src = p.w_pp;   K = 256;  Nsrc = 1024; }
        const int nkt = K >> 6;
        const int n0 = (lt / nkt) * 64, k0 = (lt % nkt) * 64;
        const int n = n0 + (tid & 63);
        const int sc = (job == 0) ? src_col_in(n) : ((job == 2) ? src_col_up(n) : n);
#pragma unroll
        for (int i = 0; i < 8; ++i) {
          const int kk = (tid >> 6) + 8 * i;
          float x = src[(size_t)(k0 + kk) * Nsrc + sc];
          if (scale) x *= scale[k0 + kk];
          v[q][i] = x;
        }
      }
#pragma unroll
      for (int q = 0; q < 4; ++q)
#pragma unroll
        for (int i = 0; i < 8; ++i) tl[q * 4160 + (tid & 63) * 65 + (tid >> 6) + 8 * i] = v[q][i];
      __syncthreads();
#pragma unroll
      for (int q = 0; q < 4; ++q) {
        const int tile = grp * 4 + q;
        u16* dst; int K, lt;
        if (tile < T0)      { lt = tile;      dst = ws16 + OFF_WIN / 2;  K = 1024; }
        else if (tile < T1) { lt = tile - T0; dst = ws16 + OFF_WOUT / 2; K = 1024; }
        else if (tile < T2) { lt = tile - T1; dst = ws16 + OFF_WUP / 2;  K = 1024; }
        else if (tile < T3) { lt = tile - T2; dst = ws16 + OFF_WDN / 2;  K = 2816; }
        else if (tile < T4) { lt = tile - T3; dst = ws16 + OFF_WPG / 2;  K = 1024; }
        else                { lt = tile - T4; dst = ws16 + OFF_WPP / 2;  K = 256; }
        const int nkt = K >> 6;
        const int n0 = (lt / nkt) * 64, k0 = (lt % nkt) * 64;
        const int kk = tid & 63;
#pragma unroll
        for (int i = 0; i < 8; ++i) {
          const int nn = (tid >> 6) + 8 * i;
          dst[(size_t)(n0 + nn) * K + k0 + kk] = f2bf(tl[q * 4160 + nn * 65 + kk]);
        }
      }
    }
    __syncthreads();
  }
  {
    u16* pb = ws16 + OFF_PB / 2;
    const size_t ngrp = (size_t)NTOK * 256 / 8;
    const size_t stride = (size_t)gridDim.x * 512;
    for (size_t g0 = (size_t)blockIdx.x * 512 + tid; g0 < ngrp; g0 += 4 * stride) {
      float4 a[4], b[4];
#pragma unroll
      for (int q = 0; q < 4; ++q) {
        const size_t g = g0 + q * stride;
        if (g < ngrp) { const float4* sp = reinterpret_cast<const float4*>(p.p + g * 8); a[q] = sp[0]; b[q] = sp[1]; }
      }
#pragma unroll
      for (int q = 0; q < 4; ++q) {
        const size_t g = g0 + q * stride;
        if (g < ngrp) {
          uint4 o;
          o.x = pack2(a[q].x, a[q].y); o.y = pack2(a[q].z, a[q].w); o.z = pack2(b[q].x, b[q].y); o.w = pack2(b[q].z, b[q].w);
          *reinterpret_cast<uint4*>(pb + g * 8) = o;
        }
      }
    }
  }
  {
    u16* UL = reinterpret_cast<u16*>(smem);
    u16* WG = reinterpret_cast<u16*>(smem + 66048);
    float* AL = reinterpret_cast<float*>(smem + 99072);
    float* HTOT = reinterpret_cast<float*>(smem + 103168);
    for (int e = tid; e < 16 * 1024; e += 512) {
      const int r = e & 15, k = e >> 4;
      WG[r * 1032 + k] = f2bf(p.w_in[(size_t)k * 3088 + 1536 + r]);
    }
    __syncthreads();
    const int wave = tid >> 6, lane = tid & 63;
    u16* u0 = ws16 + OFF_U0 / 2;
    float2* rope = reinterpret_cast<float2*>(p.ws + OFF_ROPE);
    float* bcum = reinterpret_cast<float*>(p.ws + OFF_BCUM);
    const int gc = tid & 255, hf = tid >> 8;
    float wcol[16];
#pragma unroll
    for (int r = 0; r < 16; ++r) wcol[r] = p.w_a_up[r * 256 + gc];
    const float bac = p.b_a[gc];
    for (int ch = blockIdx.x; ch < NTOK / 64; ch += gridDim.x) {
#pragma unroll 1
      for (int half = 0; half < 2; ++half) {
        float4 xa[4][4];
#pragma unroll
        for (int rq = 0; rq < 4; ++rq)
#pragma unroll
          for (int i = 0; i < 4; ++i)
            { const f32x4 t_ = __builtin_nontemporal_load(reinterpret_cast<const f32x4*>(p.x + (size_t)(ch * 64 + half * 32 + wave * 4 + rq) * 1024 + i * 256 + lane * 4));
              xa[rq][i] = make_float4(t_[0], t_[1], t_[2], t_[3]); }
#pragma unroll
        for (int rq = 0; rq < 4; ++rq) {
          const int rl = wave * 4 + rq;
          const int row = ch * 64 + half * 32 + rl;
          float4 xv[4];
          float ss = 0.f;
#pragma unroll
          for (int i = 0; i < 4; ++i) {
            xv[i] = xa[rq][i];
            ss += xv[i].x * xv[i].x + xv[i].y * xv[i].y + xv[i].z * xv[i].z + xv[i].w * xv[i].w;
          }
#pragma unroll
          for (int o = 32; o >= 1; o >>= 1) ss += __shfl_xor(ss, o);
          const float r = rsqrtf(ss * (1.0f / 1024.0f) + EPS);
#pragma unroll
          for (int i = 0; i < 4; ++i) {
            const float4 g = *reinterpret_cast<const float4*>(p.norm_mix + i * 256 + lane * 4);
            const s16x4 pk = pack4(xv[i].x * r * g.x, xv[i].y * r * g.y, xv[i].z * r * g.z, xv[i].w * r * g.w);
            *reinterpret_cast<s16x4*>(u0 + (size_t)row * 1024 + i * 256 + lane * 4) = pk;
            *reinterpret_cast<s16x4*>(UL + rl * 1032 + i * 256 + lane * 4) = pk;
          }
          if (lane >= 32) {
            const int f = lane - 32;
            const float invf = exp2f(-(float)f * (13.287712379549449f / 32.0f));
            const float ang = (float)p.pos[row] * invf;
            const double a = (double)ang;
            const double n = rint(a * 0.15915494309189535);
            const float red = (float)(a - n * 6.283185307179586);
            rope[(size_t)row * 32 + f] = make_float2(__cosf(red), __sinf(red));
          }
        }
        lds_barrier();
        if (wave < 2) {
          const int fr = lane & 15, fq = lane >> 4;
          f32x4 c0 = f32x4{0.f, 0.f, 0.f, 0.f}, c1 = f32x4{0.f, 0.f, 0.f, 0.f};
#pragma unroll 4
          for (int k0 = 0; k0 < 1024; k0 += 64) {
            const bf16x8 a0 = *reinterpret_cast<const bf16x8*>(UL + (wave * 16 + fr) * 1032 + k0 + fq * 8);
            const bf16x8 b0 = *reinterpret_cast<const bf16x8*>(WG + fr * 1032 + k0 + fq * 8);
            const bf16x8 a1 = *reinterpret_cast<const bf16x8*>(UL + (wave * 16 + fr) * 1032 + k0 + 32 + fq * 8);
            const bf16x8 b1 = *reinterpret_cast<const bf16x8*>(WG + fr * 1032 + k0 + 32 + fq * 8);
            c0 = __builtin_amdgcn_mfma_f32_16x16x32_bf16(a0, b0, c0, 0, 0, 0);
            c1 = __builtin_amdgcn_mfma_f32_16x16x32_bf16(a1, b1, c1, 0, 0, 0);
          }
#pragma unroll
          for (int j = 0; j < 4; ++j) AL[(half * 32 + wave * 16 + fq * 4 + j) * 16 + fr] = c0[j] + c1[j];
        }
        lds_barrier();
      }
      lds_barrier();
      float cum[32];
      float run = 0.f;
#pragma unroll
      for (int t = 0; t < 32; ++t) {
        float lg = bac;
#pragma unroll
        for (int r = 0; r < 16; ++r) lg += AL[(hf * 32 + t) * 16 + r] * wcol[r];
        const float ls = fminf(lg, 0.f) - __logf(1.0f + __expf(-fabsf(lg)));
        run += ls * (1.0f / 16.0f);
        cum[t] = run;
      }
      if (hf == 0) HTOT[gc] = run;
      lds_barrier();
      const float off = hf ? HTOT[gc] : 0.f;
#pragma unroll
      for (int t = 0; t < 32; ++t) bcum[(size_t)(ch * 64 + hf * 32 + t) * 256 + gc] = cum[t] + off;
    }
    __syncthreads();
  }
}

constexpr int BM = 256, BK = 64, HALF = 128, HT = HALF * BK;
DI int lds_byte(int r, int c) {
  int st = (r >> 4) * 2 + (c >> 5), rr = r & 15, cc = c & 31, ob = rr * 64 + cc * 2;
  return st * 1024 + (ob ^ (((ob >> 9) & 1) << 5));
}
DI void stage_rc(int b, int& R, int& C) {
  int st = b / 1024, sb = b % 1024, swz = sb ^ (((sb >> 9) & 1) << 5);
  R = (st >> 1) * 16 + swz / 64; C = (st & 1) * 32 + (swz % 64) / 2;
}

__device__ void phase_final_rows(const Params& p, const int wv, const int row0);
enum { EPI_IN = 0, EPI_RES = 1, EPI_UP = 2, EPI_PP = 3, EPI_PLE = 4, EPI_NONE = 5 };

struct EpiArgs {
  const float* res;
  float* ssq_out;
  const float* ssq_in;
};

template <int EPI, bool FUSED = true>
__device__ __forceinline__ void gemm_tile(const u16* __restrict__ A, const u16* __restrict__ Bt, const int K,
                                          const int brow, const int bcol, const Params& p, const EpiArgs& ea, const int wv,
                                          const bool pro_done, const bool has_next, const int nbrow, const int nbcol) {
  u16* shm = reinterpret_cast<u16*>(smem);
#define SA(b, h) (shm + ((b) * 2 + (h)) * HT)
#define SB(b, h) (shm + (4 + (b) * 2 + (h)) * HT)
#define STAGE(P, BASE, br, kt) do { const size_t _g = (size_t)(br) * K + (size_t)(kt) * BK; \
    _Pragma("unroll") for (int _i = 0; _i < 2; ++_i) { int _b = tidK * 16 + _i * 8192; int _r, _c; stage_rc(_b, _r, _c); \
      __builtin_amdgcn_global_load_lds((const unsigned*)(BASE + _g + (size_t)_r * K + _c), \
        (unsigned*)((char*)(P) + _b), 16, 0, 0); } } while (0)
#define STAGEB(P, BASE, br, kt) do { const size_t _g = (size_t)(br) * K + (size_t)(kt) * BK; \
    _Pragma("unroll") for (int _i = 0; _i < 2; ++_i) { int _b = tidK * 16 + _i * 8192; int _r, _c; stage_rc(_b, _r, _c); \
      const int _rho = _r & 31; _r = (_r & ~31) | (8 * ((_rho & 15) >> 2) + 4 * (_rho >> 4) + (_rho & 3)); \
      __builtin_amdgcn_global_load_lds((const unsigned*)(BASE + _g + (size_t)_r * K + _c), \
        (unsigned*)((char*)(P) + _b), 16, 0, 0); } } while (0)
#define LDA(dst, b, h) _Pragma("unroll") for (int m = 0; m < 4; ++m) _Pragma("unroll") for (int k = 0; k < 2; ++k) \
    dst[m][k] = *reinterpret_cast<const bf16x8*>((char*)SA(b, h) + lds_byte(wr * 64 + m * 16 + fr, k * 32 + fq * 8))
#define LDB(dst, b, h) _Pragma("unroll") for (int n = 0; n < 2; ++n) _Pragma("unroll") for (int k = 0; k < 2; ++k) \
    dst[n][k] = *reinterpret_cast<const bf16x8*>((char*)SB(b, h) + lds_byte(wc * 32 + n * 16 + fr, k * 32 + fq * 8))
#define MMA(ai, bj, At_, Bt_) do { __builtin_amdgcn_s_setprio(1); \
    _Pragma("unroll") for (int m = 0; m < 4; ++m) _Pragma("unroll") for (int n = 0; n < 2; ++n) _Pragma("unroll") for (int k = 0; k < 2; ++k) \
      acc[ai][bj][m][n] = __builtin_amdgcn_mfma_f32_16x16x32_bf16(Bt_[n][k], At_[m][k], acc[ai][bj][m][n], 0, 0, 0); \
    __builtin_amdgcn_s_setprio(0); } while (0)
#define WAIT_V(n) asm volatile("s_waitcnt vmcnt(" #n ")" ::: "memory")
#define WAIT_L(n) asm volatile("s_waitcnt lgkmcnt(" #n ")" ::: "memory")
#define BAR __builtin_amdgcn_s_barrier()
#define SCHED __builtin_amdgcn_sched_barrier(0)

  f32x4 acc[2][2][4][2];
  {
  const int tidK = tid_fresh(wv);
  const int wid = tidK >> 6, lane = tidK & 63, wr = wid >> 2, wc = wid & 3, fr = lane & 15, fq = lane >> 4;
#pragma unroll
  for (int a = 0; a < 2; ++a)
#pragma unroll
    for (int b = 0; b < 2; ++b)
#pragma unroll
      for (int m = 0; m < 4; ++m)
#pragma unroll
        for (int n = 0; n < 2; ++n) acc[a][b][m][n] = f32x4{0.f, 0.f, 0.f, 0.f};
  bf16x8 At[4][2], B0[2][2], B1[2][2];
  const int nt = K / BK;
  if (!pro_done) {
    STAGEB(SB(0, 0), Bt, bcol, 0); STAGE(SA(0, 0), A, brow, 0);
    STAGEB(SB(0, 1), Bt, bcol + HALF, 0); STAGE(SA(0, 1), A, brow + HALF, 0);
  }
  if (wr == 1) BAR;
  WAIT_V(4); BAR;
  STAGEB(SB(1, 0), Bt, bcol, 1); STAGE(SA(1, 0), A, brow, 1); STAGEB(SB(1, 1), Bt, bcol + HALF, 1);
  WAIT_V(6); BAR;
  for (int t = 0; t < nt - 2; t += 2) {
    LDB(B0, 0, 0); SCHED; LDA(At, 0, 0); STAGE(SA(1, 1), A, brow + HALF, t + 1);
    WAIT_L(8); BAR; WAIT_L(0); MMA(0, 0, At, B0); BAR; SCHED;
    LDB(B1, 0, 1); STAGEB(SB(0, 0), Bt, bcol, t + 2);
    BAR; WAIT_L(0); MMA(0, 1, At, B1); BAR;
    LDA(At, 0, 1); STAGE(SA(0, 0), A, brow, t + 2);
    BAR; WAIT_L(0); MMA(1, 0, At, B0); BAR; SCHED;
    STAGEB(SB(0, 1), Bt, bcol + HALF, t + 2);
    WAIT_V(6); BAR; MMA(1, 1, At, B1); BAR;
    LDB(B0, 1, 0); SCHED; LDA(At, 1, 0); STAGE(SA(0, 1), A, brow + HALF, t + 2);
    WAIT_L(8); BAR; WAIT_L(0); MMA(0, 0, At, B0); BAR; SCHED;
    LDB(B1, 1, 1); STAGEB(SB(1, 0), Bt, bcol, t + 3);
    BAR; WAIT_L(0); MMA(0, 1, At, B1); BAR;
    LDA(At, 1, 1); STAGE(SA(1, 0), A, brow, t + 3);
    BAR; WAIT_L(0); MMA(1, 0, At, B0); BAR; SCHED;
    STAGEB(SB(1, 1), Bt, bcol + HALF, t + 3);
    WAIT_V(6); BAR; MMA(1, 1, At, B1); BAR;
  }
  { LDB(B0, 0, 0); LDA(At, 0, 0); STAGE(SA(1, 1), A, brow + HALF, nt - 1);
    BAR; WAIT_L(0); MMA(0, 0, At, B0); BAR;
    LDB(B1, 0, 1); BAR; WAIT_L(0); MMA(0, 1, At, B1); BAR;
    LDA(At, 0, 1); WAIT_V(4); BAR; WAIT_L(0); MMA(1, 0, At, B0); MMA(1, 1, At, B1); BAR; }
  { LDB(B0, 1, 0); LDA(At, 1, 0); WAIT_V(2); BAR; WAIT_L(0); MMA(0, 0, At, B0); BAR;
    LDB(B1, 1, 1); WAIT_V(0); BAR; WAIT_L(0); MMA(0, 1, At, B1); BAR;
    LDA(At, 1, 1); BAR; WAIT_L(0); MMA(1, 0, At, B0); MMA(1, 1, At, B1); BAR; }
  if (wr == 0) BAR;
  if (has_next) {
    const int tidK = tid_fresh(wv);
    STAGEB(SB(0, 0), Bt, nbcol, 0); STAGE(SA(0, 0), A, nbrow, 0);
    STAGEB(SB(0, 1), Bt, nbcol + HALF, 0); STAGE(SA(0, 1), A, nbrow + HALF, 0);
  }
  }
  const int tidE = tid_fresh(wv);
  const int wr = tidE >> 8, wc = (tidE >> 6) & 3, fr = tidE & 15, fq = (tidE >> 4) & 3;
#undef SA
#undef SB
#undef STAGE
#undef STAGEB
#undef LDA
#undef LDB
#undef MMA

  u16* ws16 = reinterpret_cast<u16*>(p.ws);
  if constexpr (EPI == EPI_IN) {
    const int ntile = bcol >> 8;
    u16* zb = ws16 + OFF_ZB / 2;
    if (ntile == 2 || ntile == 3 || ntile == 10 || ntile == 11) {
      u16* vt = ws16 + ((ntile < 4) ? OFF_VTG : OFF_VTD) / 2;
      const int cbase = (ntile < 4) ? 512 : 2560;
      u16* Tt = reinterpret_cast<u16*>(smem);
      lds_barrier();
#pragma unroll
      for (int ai = 0; ai < 2; ++ai)
#pragma unroll
        for (int m = 0; m < 4; ++m) {
          SCHED; const int tl = ai * 128 + wr * 64 + m * 16 + fr;
#pragma unroll
          for (int bj = 0; bj < 2; ++bj)
#pragma unroll
            for (int n = 0; n < 2; ++n) {
              const int cl = bj * 128 + wc * 32 + fq * 8 + n * 4;
#pragma unroll
              for (int j = 0; j < 4; ++j) Tt[(cl + j) * 264 + tl] = f2bf(acc[ai][bj][m][n][j]);
            }
        }
      lds_barrier();
      {
        const int bq = brow >> 12, t0 = brow & 4095;
#pragma unroll 4
        for (int i = 0; i < 16; ++i) {
          const int L = i * 512 + tidE, c = L >> 5, ch = L & 31;
          const int cv = bcol - cbase + c;
          const bf16x8 v = *reinterpret_cast<const bf16x8*>(Tt + c * 264 + ch * 8);
          *reinterpret_cast<bf16x8*>(vt + ((size_t)((bq * 4 + (cv >> 7)) * 128 + (cv & 127))) * 4096 + t0 + ch * 8) = v;
        }
      }
      lds_barrier();
    } else if (ntile >= 6 && ntile <= 9) {
      const float sc = (ntile < 8) ? (0.125f * 1.4426950408889634f) : 1.0f;
      const float4* rope = reinterpret_cast<const float4*>(p.ws + OFF_ROPE);
      float4 rt[2][4][2];
#pragma unroll
      for (int ai = 0; ai < 2; ++ai)
#pragma unroll
        for (int m = 0; m < 4; ++m) {
          const int row = brow + ai * 128 + wr * 64 + m * 16 + fr;
          const float4* tb = rope + ((size_t)row * 32 + (wc & 1) * 16 + fq * 4) / 2;
          rt[ai][m][0] = tb[0]; rt[ai][m][1] = tb[1];
        }
      SCHED;
#pragma unroll
      for (int ai = 0; ai < 2; ++ai)
#pragma unroll
        for (int m = 0; m < 4; ++m) {
          const int row = brow + ai * 128 + wr * 64 + m * 16 + fr;
          const float4 cs0 = rt[ai][m][0], cs1 = rt[ai][m][1];
          const float c[4] = {cs0.x, cs0.z, cs1.x, cs1.z};
          const float s[4] = {cs0.y, cs0.w, cs1.y, cs1.w};
#pragma unroll
          for (int bj = 0; bj < 2; ++bj) {
            const f32x4 x1 = acc[ai][bj][m][0], x2 = acc[ai][bj][m][1];
            float o1[4], o2[4];
#pragma unroll
            for (int j = 0; j < 4; ++j) {
              o1[j] = (x1[j] * c[j] - x2[j] * s[j]) * sc;
              o2[j] = (x2[j] * c[j] + x1[j] * s[j]) * sc;
            }
            const int col = bcol + bj * 128 + wc * 32 + fq * 8;
            *reinterpret_cast<uint4*>(zb + (size_t)row * NIN + col) = pack8(o1, o2);
          }
        }
    } else if (ntile < 2) {
      const float* bcum = reinterpret_cast<const float*>(p.ws + OFF_BCUM);
      u16* kdt = ws16 + OFF_KDT / 2;
      u16* Tt = reinterpret_cast<u16*>(smem);
      lds_barrier();
#pragma unroll
      for (int ai = 0; ai < 2; ++ai) {
        float4 bq4[4][2][2], lq4[2][2];
        SCHED;
#pragma unroll
        for (int bj = 0; bj < 2; ++bj)
#pragma unroll
          for (int n = 0; n < 2; ++n) {
            const int cg = bj * 128 + wc * 32 + fq * 8 + n * 4;
            lq4[bj][n] = *reinterpret_cast<const float4*>(bcum + (size_t)((brow + ai * 128 + wr * 64) | 63) * 256 + cg);
#pragma unroll
            for (int m = 0; m < 4; ++m)
              bq4[m][bj][n] = *reinterpret_cast<const float4*>(bcum + (size_t)(brow + ai * 128 + wr * 64 + m * 16 + fr) * 256 + cg);
          }
        SCHED;
#pragma unroll
        for (int m = 0; m < 4; ++m) {
          const int row = brow + ai * 128 + wr * 64 + m * 16 + fr;
#pragma unroll
          for (int bj = 0; bj < 2; ++bj) {
            float f[2][4], g[2][4];
#pragma unroll
            for (int n = 0; n < 2; ++n) {
              const int cg = bj * 128 + wc * 32 + fq * 8 + n * 4;
              const float4 b4 = bq4[m][bj][n];
              const float bb[4] = {b4.x, b4.y, b4.z, b4.w};
              const f32x4 v = acc[ai][bj][m][n];
              if (ntile == 0) {
#pragma unroll
                for (int j = 0; j < 4; ++j) { const float q = v[j] * 0.125f; f[n][j] = q * __expf(bb[j]); g[n][j] = q * __expf(-bb[j]); }
              } else {
                const float4 l4 = lq4[bj][n];
                const float bl[4] = {l4.x, l4.y, l4.z, l4.w};
#pragma unroll
                for (int j = 0; j < 4; ++j) { f[n][j] = v[j] * __expf(bb[j]); g[n][j] = v[j] * __expf(-bb[j]); }
                const int tl = ai * 128 + wr * 64 + m * 16 + fr;
#pragma unroll
                for (int j = 0; j < 4; ++j) Tt[(cg + j) * 264 + tl] = f2bf(v[j] * __expf(bl[j] - bb[j]));
              }
            }
            const int c8 = bj * 128 + wc * 32 + fq * 8;
            const int o1 = (ntile == 0) ? 0 : 256, o2 = (ntile == 0) ? 512 : 768;
            *reinterpret_cast<uint4*>(zb + (size_t)row * NIN + o1 + c8) = pack8(f[0], f[1]);
            *reinterpret_cast<uint4*>(zb + (size_t)row * NIN + o2 + c8) = pack8(g[0], g[1]);
          }
        }
      }
      lds_barrier();
      if (ntile == 1) {
        const int bq = brow >> 12, t0 = brow & 4095;
#pragma unroll 4
        for (int i = 0; i < 16; ++i) {
          const int L = i * 512 + tidE, c = L >> 5, ch = L & 31;
          const bf16x8 v = *reinterpret_cast<const bf16x8*>(Tt + c * 264 + ch * 8);
          *reinterpret_cast<bf16x8*>(kdt + ((size_t)((bq * 4 + (c >> 6)) * 64 + (c & 63))) * 4096 + t0 + ch * 8) = v;
        }
      }
      lds_barrier();
    } else {
#pragma unroll
      for (int ai = 0; ai < 2; ++ai)
#pragma unroll
        for (int m = 0; m < 4; ++m) {
          SCHED; const int row = brow + ai * 128 + wr * 64 + m * 16 + fr;
#pragma unroll
          for (int bj = 0; bj < 2; ++bj) {
            float sg[2][4];
#pragma unroll
            for (int n = 0; n < 2; ++n) {
              const f32x4 v = acc[ai][bj][m][n];
#pragma unroll
              for (int j = 0; j < 4; ++j) sg[n][j] = v[j] * __builtin_amdgcn_rcpf(1.0f + __expf(-v[j]));
            }
            *reinterpret_cast<uint4*>(zb + (size_t)row * NIN + bcol + bj * 128 + wc * 32 + fq * 8) = pack8(sg[0], sg[1]);
          }
        }
    }
  } else if constexpr (EPI == EPI_RES) {
    u16* hb = ws16 + OFF_U0 / 2;
    const int wvE = tidE >> 6, lnE = tidE & 63;
#pragma unroll
    for (int ai = 0; ai < 2; ++ai)
#pragma unroll
      for (int m = 0; m < 4; ++m) {
        SCHED;
        float* F = reinterpret_cast<float*>(smem + ((m & 1) ? 98304 : 32768));
        float4 xr[4];
#pragma unroll
        for (int rr = 0; rr < 4; ++rr) {
          const int rl = wvE * 4 + rr;
          const int grow = brow + ai * 128 + (rl >> 4) * 64 + m * 16 + (rl & 15);
          xr[rr] = *reinterpret_cast<const float4*>(ea.res + (size_t)grow * DM + bcol + lnE * 4);
        }
#pragma unroll
        for (int bj = 0; bj < 2; ++bj)
#pragma unroll
          for (int n = 0; n < 2; ++n) {
            const int chunk = (bj * 128 + wc * 32 + fq * 8 + n * 4) >> 2;
            *reinterpret_cast<f32x4*>(F + (wr * 16 + fr) * 256 + ((chunk ^ fr) << 2)) = acc[ai][bj][m][n];
          }
        lds_barrier();
#pragma unroll
        for (int rr = 0; rr < 4; ++rr) {
          const int rl = wvE * 4 + rr;
          const int grow = brow + ai * 128 + (rl >> 4) * 64 + m * 16 + (rl & 15);
          const float4 v = *reinterpret_cast<const float4*>(F + rl * 256 + ((lnE ^ (rl & 15)) << 2));
          const float h0 = xr[rr].x + v.x, h1 = xr[rr].y + v.y, h2 = xr[rr].z + v.z, h3 = xr[rr].w + v.w;
          *reinterpret_cast<float4*>(p.out + (size_t)grow * DM + bcol + lnE * 4) = make_float4(h0, h1, h2, h3);
          *reinterpret_cast<s16x4*>(hb + (size_t)grow * DM + bcol + lnE * 4) = pack4(h0, h1, h2, h3);
          float ss = h0 * h0 + h1 * h1 + h2 * h2 + h3 * h3;
          ss += __shfl_xor(ss, 1); ss += __shfl_xor(ss, 2); ss += __shfl_xor(ss, 4); ss += __shfl_xor(ss, 8);
          ss = xor16_sum(ss);
          ss = xor32_sum(ss);
          if (lnE == 0) ea.ssq_out[(size_t)grow * 4 + (bcol >> 8)] = ss;
        }
      }
    lds_barrier();
  } else if constexpr (EPI == EPI_NONE) {
    float sm = 0.f;
#pragma unroll
    for (int ai = 0; ai < 2; ++ai)
#pragma unroll
      for (int bj = 0; bj < 2; ++bj)
#pragma unroll
        for (int m = 0; m < 4; ++m)
#pragma unroll
          for (int n = 0; n < 2; ++n) sm += acc[ai][bj][m][n][0] + acc[ai][bj][m][n][1] + acc[ai][bj][m][n][2] + acc[ai][bj][m][n][3];
    if (sm == 1.2345e30f) reinterpret_cast<float*>(p.ws + OFF_HALO)[tidE] = sm;
  } else if constexpr (EPI == EPI_PP) {
    u16* pp = ws16 + OFF_OB / 2;
#pragma unroll
    for (int ai = 0; ai < 2; ++ai)
#pragma unroll
      for (int m = 0; m < 4; ++m) {
        SCHED; const int row = brow + ai * 128 + wr * 64 + m * 16 + fr;
#pragma unroll
        for (int bj = 0; bj < 2; ++bj)
#pragma unroll
          for (int n = 0; n < 2; n += 2) {
            const int col = bcol + bj * 128 + wc * 32 + fq * 8;
            const f32x4 v0 = acc[ai][bj][m][0], v1 = acc[ai][bj][m][1];
            const float a0[4] = {v0[0], v0[1], v0[2], v0[3]}, a1[4] = {v1[0], v1[1], v1[2], v1[3]};
            *reinterpret_cast<uint4*>(pp + (size_t)row * DM + col) = pack8(a0, a1);
          }
      }
  } else if constexpr (EPI == EPI_PLE) {
    const u16* pp = ws16 + OFF_OB / 2;
    unsigned long long* slots = reinterpret_cast<unsigned long long*>(p.ws + OFF_SLOT);
    constexpr bool fused = FUSED;
#pragma unroll
    for (int ai = 0; ai < 2; ++ai)
#pragma unroll
      for (int m = 0; m < 4; ++m) {
        SCHED; const int row = brow + ai * 128 + wr * 64 + m * 16 + fr;
        const float r2 = rs4(ea.ssq_in, row);
        float ss = 0.f;
#pragma unroll
        for (int bj = 0; bj < 2; ++bj)
#pragma unroll
          for (int n = 0; n < 2; ++n) {
            const int col = bcol + bj * 128 + wc * 32 + fq * 8 + n * 4;
            const float4 hr = *reinterpret_cast<const float4*>(p.out + (size_t)row * DM + col);
            const s16x4 pv = *reinterpret_cast<const s16x4*>(pp + (size_t)row * DM + col);
            const f32x4 v = acc[ai][bj][m][n];
            float h[4] = {hr.x, hr.y, hr.z, hr.w};
#pragma unroll
            for (int j = 0; j < 4; ++j) {
              const float g = __builtin_amdgcn_rcpf(1.0f + __expf(-v[j] * r2));
              h[j] += g * bf2f((u16)pv[j]);
              ss += h[j] * h[j];
            }
            acc[ai][bj][m][n] = f32x4{h[0], h[1], h[2], h[3]};
            if (!fused) *reinterpret_cast<float4*>(p.out + (size_t)row * DM + col) = make_float4(h[0], h[1], h[2], h[3]);
          }
        ss = xor16_sum(ss);
        ss = xor32_sum(ss);
        if (fq == 0) {
          if (fused) {
            const unsigned long long pk = ((unsigned long long)1u << 32) | (unsigned long long)__float_as_uint(ss);
            __hip_atomic_store(slots + (size_t)row * 16 + (bcol >> 8) * 4 + wc, pk, __ATOMIC_RELAXED, __HIP_MEMORY_SCOPE_AGENT);
          } else {
            ea.ssq_out[(size_t)row * 16 + (bcol >> 8) * 4 + wc] = ss;
          }
        }
      }
    SCHED;
    if (fused)
#pragma unroll
    for (int ai = 0; ai < 2; ++ai)
#pragma unroll
      for (int m = 0; m < 4; ++m) {
        SCHED; const int row = brow + ai * 128 + wr * 64 + m * 16 + fr;
        float part = 0.f;
#pragma unroll
        for (int k = 0; k < 4; ++k) {
          unsigned long long* sp = slots + (size_t)row * 16 + fq * 4 + k;
          unsigned long long vv = __hip_atomic_load(sp, __ATOMIC_RELAXED, __HIP_MEMORY_SCOPE_AGENT);
          unsigned spins = 0;
          while ((unsigned)(vv >> 32) != 1u && ++spins < (1u << 22)) {
            __builtin_amdgcn_s_sleep(1);
            vv = __hip_atomic_load(sp, __ATOMIC_RELAXED, __HIP_MEMORY_SCOPE_AGENT);
          }
          part += __uint_as_float((unsigned)vv);
        }
        part = xor16_sum(part);
        part = xor32_sum(part);
        const float r3 = rsqrtf(part * (1.0f / 1024.0f) + EPS);
#pragma unroll
        for (int bj = 0; bj < 2; ++bj)
#pragma unroll
          for (int n = 0; n < 2; ++n) {
            const int col = bcol + bj * 128 + wc * 32 + fq * 8 + n * 4;
            const float4 g4 = *reinterpret_cast<const float4*>(p.norm_final + col);
            const f32x4 h = acc[ai][bj][m][n];
            *reinterpret_cast<float4*>(p.out + (size_t)row * DM + col) =
                make_float4(h[0] * r3 * g4.x, h[1] * r3 * g4.y, h[2] * r3 * g4.z, h[3] * r3 * g4.w);
          }
      }
  } else if constexpr (EPI == EPI_UP) {
    float* T = reinterpret_cast<float*>(smem);
    float* Hh = T + 128 * 260;
    float* halo = reinterpret_cast<float*>(p.ws + OFF_HALO);
    u16* ab = ws16 + OFF_ZB / 2;
    const int ntile = bcol >> 8, mtile = brow >> 8;
    const int tid = tidE;
    const int c4 = (tid & 31) * 4;
    const int f = ntile * 128 + c4;
    float r1v[2][4];
#pragma unroll
    for (int ai = 0; ai < 2; ++ai)
#pragma unroll
      for (int m = 0; m < 4; ++m) r1v[ai][m] = rs4(ea.ssq_in, brow + ai * 128 + wr * 64 + m * 16 + fr);
    SCHED;
#pragma unroll
    for (int ai = 0; ai < 2; ++ai) {
      lds_barrier();
#pragma unroll
      for (int m = 0; m < 4; ++m) {
        const int rl = wr * 64 + m * 16 + fr;
        const float r1 = r1v[ai][m];
#pragma unroll
        for (int bj = 0; bj < 2; ++bj)
#pragma unroll
          for (int n = 0; n < 2; ++n) {
            const int cl = bj * 128 + wc * 32 + fq * 8 + n * 4;
            const f32x4 v = acc[ai][bj][m][n];
            *reinterpret_cast<float4*>(T + rl * 260 + cl) = make_float4(v[0] * r1, v[1] * r1, v[2] * r1, v[3] * r1);
          }
      }
      lds_barrier();
      SCHED;
      float4 wg[3], wv[3];
#pragma unroll
      for (int j = 0; j < 3; ++j) {
        wg[j] = *reinterpret_cast<const float4*>(p.conv_w + (size_t)j * NUP + f);
        wv[j] = *reinterpret_cast<const float4*>(p.conv_w + (size_t)j * NUP + NFF + f);
      }
      const float4 bg = *reinterpret_cast<const float4*>(p.conv_b + f);
      const float4 bv = *reinterpret_cast<const float4*>(p.conv_b + NFF + f);
#pragma unroll 1
      for (int i = 0; i < 8; ++i) {
        const int rl = (tid >> 5) + 16 * i;
        const int row = brow + ai * 128 + rl;
        const float4 u2g = *reinterpret_cast<const float4*>(T + rl * 260 + c4);
        const float4 u2v = *reinterpret_cast<const float4*>(T + rl * 260 + 128 + c4);
        if (ai == 0 && rl < 2) {
          float* hd = halo + ((size_t)(mtile * 4 + rl)) * NUP + ntile * 256 + c4;
          *reinterpret_cast<float4*>(hd) = u2g;
          *reinterpret_cast<float4*>(hd + 128) = u2v;
          continue;
        }
        if (ai == 1 && rl >= 126) {
          float* hd = halo + ((size_t)(mtile * 4 + 2 + (rl - 126))) * NUP + ntile * 256 + c4;
          *reinterpret_cast<float4*>(hd) = u2g;
          *reinterpret_cast<float4*>(hd + 128) = u2v;
        }
        if (ai == 0 && rl >= 126) {
          *reinterpret_cast<float4*>(Hh + (rl - 126) * 256 + c4) = u2g;
          *reinterpret_cast<float4*>(Hh + (rl - 126) * 256 + 128 + c4) = u2v;
        }
        const float* p1 = (rl >= 1) ? (T + (rl - 1) * 260) : (Hh + 256);
        const float* p0 = (rl >= 2) ? (T + (rl - 2) * 260) : (Hh + rl * 256);
        const float4 u1g = *reinterpret_cast<const float4*>(p1 + c4);
        const float4 u1v = *reinterpret_cast<const float4*>(p1 + 128 + c4);
        const float4 u0g = *reinterpret_cast<const float4*>(p0 + c4);
        const float4 u0v = *reinterpret_cast<const float4*>(p0 + 128 + c4);
        const float cg0 = bg.x + wg[0].x * u0g.x + wg[1].x * u1g.x + wg[2].x * u2g.x;
        const float cg1 = bg.y + wg[0].y * u0g.y + wg[1].y * u1g.y + wg[2].y * u2g.y;
        const float cg2 = bg.z + wg[0].z * u0g.z + wg[1].z * u1g.z + wg[2].z * u2g.z;
        const float cg3 = bg.w + wg[0].w * u0g.w + wg[1].w * u1g.w + wg[2].w * u2g.w;
        const float cv0 = bv.x + wv[0].x * u0v.x + wv[1].x * u1v.x + wv[2].x * u2v.x;
        const float cv1 = bv.y + wv[0].y * u0v.y + wv[1].y * u1v.y + wv[2].y * u2v.y;
        const float cv2 = bv.z + wv[0].z * u0v.z + wv[1].z * u1v.z + wv[2].z * u2v.z;
        const float cv3 = bv.w + wv[0].w * u0v.w + wv[1].w * u1v.w + wv[2].w * u2v.w;
        *reinterpret_cast<s16x4*>(ab + (size_t)row * NFF + f) =
            pack4(gelu_tanh(cg0) * cv0, gelu_tanh(cg1) * cv1, gelu_tanh(cg2) * cv2, gelu_tanh(cg3) * cv3);
      }
    }
    lds_barrier();
  }
}

DI void tile_map(int t, int nM, int nN, int& pm, int& pn) {
  const int nwg = nM * nN;
  const int q = nwg / 8, r = nwg % 8, xcd = t % 8, off = t / 8;
  int w = (xcd < r ? xcd * (q + 1) : r * (q + 1) + (xcd - r) * q) + off;
  const int nig = 8 * nN, gid = w / nig, fm = gid * 8;
  const int gsz = min(nM - fm, 8);
  pm = fm + ((w % nig) % gsz);
  pn = (w % nig) / gsz;
}

DI f32x4 mma16(const u16* A, int lda, const u16* B, int ldb, int K, f32x4 acc, int fr, int fq) {
  for (int k0 = 0; k0 < K; k0 += 32) {
    const bf16x8 a = *reinterpret_cast<const bf16x8*>(A + fr * lda + k0 + fq * 8);
    const bf16x8 b = *reinterpret_cast<const bf16x8*>(B + fr * ldb + k0 + fq * 8);
    acc = __builtin_amdgcn_mfma_f32_16x16x32_bf16(a, b, acc, 0, 0, 0);
  }
  return acc;
}


__device__ void gla_chain(const Params& p, const int wv, const int b, const int h) {
  const int tid = tid_fresh(wv), w = tid >> 6, lane = tid & 63, fr = lane & 15, fq = lane >> 4;
  u16* ws16 = reinterpret_cast<u16*>(p.ws);
  const u16* zb = ws16 + OFF_ZB / 2;
  const u16* vtg = ws16 + OFF_VTG / 2 + (size_t)((b * 4 + h) * 128) * 4096;
  const u16* kdtg = ws16 + OFF_KDT / 2 + (size_t)((b * 4 + h) * 64) * 4096;
  const float* bcum = reinterpret_cast<const float*>(p.ws + OFF_BCUM);
  u16* ob = ws16 + OFF_OB / 2;
  constexpr int LD = 72;
  float* DEC = reinterpret_cast<float*>(smem);
  u16* QF  = reinterpret_cast<u16*>(smem + 16640);
  u16* QN  = reinterpret_cast<u16*>(smem + 25856);
  u16* KF  = reinterpret_cast<u16*>(smem + 35072);
  u16* KN  = reinterpret_cast<u16*>(smem + 44288);
  u16* KDT = reinterpret_cast<u16*>(smem + 53504);
  u16* AM  = reinterpret_cast<u16*>(smem + 62720);
  u16* VT  = reinterpret_cast<u16*>(smem + 71936);
  u16* ST  = reinterpret_cast<u16*>(smem + 90368);
  float* SSQ  = reinterpret_cast<float*>(smem + 119296);
  float* RN   = reinterpret_cast<float*>(smem + 121344);

  __syncthreads();
  for (int e = tid; e < 128 * LD; e += 512) ST[e] = 0;
  f32x4 sacc[4];
#pragma unroll
  for (int i = 0; i < 4; ++i) sacc[i] = f32x4{0.f, 0.f, 0.f, 0.f};
  const int t_ = tid >> 3, d8 = (tid & 7) * 8;
  const float gnrm = p.gla_norm[h * 128 + w * 16 + fr];
  __syncthreads();

  bf16x8 qfn, qnn, kfn, knn, kdn, vtn[2];
  float decn = 0.f;
  u16 gn16[16];
#define GLA_LOAD(nn) do { \
    const int tb_ = b * 4096 + (nn) * 64; \
    const u16* zr_ = zb + (size_t)(tb_ + t_) * NIN + h * 64 + d8; \
    qfn = *reinterpret_cast<const bf16x8*>(zr_); \
    kfn = *reinterpret_cast<const bf16x8*>(zr_ + 256); \
    qnn = *reinterpret_cast<const bf16x8*>(zr_ + 512); \
    knn = *reinterpret_cast<const bf16x8*>(zr_ + 768); \
    kdn = *reinterpret_cast<const bf16x8*>(kdtg + (size_t)t_ * 4096 + (nn) * 64 + d8); \
    if (tid < 64) decn = bcum[(size_t)(tb_ + 63) * 256 + h * 64 + tid]; \
    _Pragma("unroll") for (int i_ = 0; i_ < 2; ++i_) { const int L_ = i_ * 512 + tid, dv_ = L_ >> 3, c_ = L_ & 7; \
      vtn[i_] = *reinterpret_cast<const bf16x8*>(vtg + (size_t)dv_ * 4096 + (nn) * 64 + c_ * 8); } \
    _Pragma("unroll") for (int tb2_ = 0; tb2_ < 4; ++tb2_) _Pragma("unroll") for (int j_ = 0; j_ < 4; ++j_) \
      gn16[tb2_ * 4 + j_] = zb[(size_t)(tb_ + tb2_ * 16 + fq * 4 + j_) * NIN + 1024 + h * 128 + w * 16 + fr]; \
  } while (0)
  GLA_LOAD(0);
#pragma unroll 1
  for (int n = 0; n < 64; ++n) {
    const int tokb = b * 4096 + n * 64;
    u16 g16[16];
#pragma unroll
    for (int i = 0; i < 16; ++i) g16[i] = gn16[i];
    *reinterpret_cast<bf16x8*>(QF + t_ * LD + d8) = qfn;
    *reinterpret_cast<bf16x8*>(QN + t_ * LD + d8) = qnn;
    *reinterpret_cast<bf16x8*>(KF + t_ * LD + d8) = kfn;
    *reinterpret_cast<bf16x8*>(KN + t_ * LD + d8) = knn;
    *reinterpret_cast<bf16x8*>(KDT + t_ * LD + d8) = kdn;
    if (tid < 64) DEC[tid] = __expf(decn);
#pragma unroll
    for (int i = 0; i < 2; ++i) {
      const int L = i * 512 + tid, dv = L >> 3, c = L & 7;
      *reinterpret_cast<bf16x8*>(VT + dv * LD + c * 8) = vtn[i];
    }
    if (n + 1 < 64) GLA_LOAD(n + 1);
    lds_barrier();
#pragma unroll
    for (int bi2 = 0; bi2 < 2; ++bi2) {
      const int bi = w * 2 + bi2, ti = bi >> 2, si = bi & 3;
      const f32x4 z4 = f32x4{0.f, 0.f, 0.f, 0.f};
      const f32x4 fw = mma16(QF + ti * 16 * LD, LD, KN + si * 16 * LD, LD, 64, z4, fr, fq);
      const f32x4 bw = mma16(QN + ti * 16 * LD, LD, KF + si * 16 * LD, LD, 64, z4, fr, fq);
#pragma unroll
      for (int j = 0; j < 4; ++j) {
        const int t = ti * 16 + fq * 4 + j, s = si * 16 + fr;
        AM[t * LD + s] = f2bf((s <= t) ? fw[j] : bw[j]);
      }
    }
    lds_barrier();
    f32x4 oacc[4];
#pragma unroll
    for (int tb = 0; tb < 4; ++tb) {
      f32x4 a = f32x4{0.f, 0.f, 0.f, 0.f};
      a = mma16(AM + tb * 16 * LD, LD, VT + w * 16 * LD, LD, 64, a, fr, fq);
      a = mma16(QF + tb * 16 * LD, LD, ST + w * 16 * LD, LD, 64, a, fr, fq);
      oacc[tb] = a;
#pragma unroll
      for (int j = 0; j < 4; ++j) {
        float v = a[j] * a[j];
        v += __shfl_xor(v, 1); v += __shfl_xor(v, 2); v += __shfl_xor(v, 4); v += __shfl_xor(v, 8);
        if (fr == 0) SSQ[(tb * 16 + fq * 4 + j) * 8 + w] = v;
      }
    }
    lds_barrier();
    if (tid < 64) {
      const float4 s0 = *reinterpret_cast<const float4*>(SSQ + tid * 8), s1 = *reinterpret_cast<const float4*>(SSQ + tid * 8 + 4);
      const float tot = (s0.x + s0.y + s0.z + s0.w) + (s1.x + s1.y + s1.z + s1.w);
      RN[tid] = rsqrtf(tot * (1.0f / 128.0f) + EPS);
    }
#pragma unroll
    for (int db = 0; db < 4; ++db) {
      const float dec = DEC[db * 16 + fr];
      f32x4 a = sacc[db];
#pragma unroll
      for (int j = 0; j < 4; ++j) a[j] *= dec;
      a = mma16(VT + w * 16 * LD, LD, KDT + db * 16 * LD, LD, 64, a, fr, fq);
      sacc[db] = a;
#pragma unroll
      for (int j = 0; j < 4; ++j) ST[(w * 16 + fq * 4 + j) * LD + db * 16 + fr] = f2bf(a[j]);
    }
    lds_barrier();
    {
      const int dv = w * 16 + fr;
#pragma unroll
      for (int tb = 0; tb < 4; ++tb) {
        const float4 rn4 = *reinterpret_cast<const float4*>(RN + tb * 16 + fq * 4);
        const float rn[4] = {rn4.x, rn4.y, rn4.z, rn4.w};
#pragma unroll
        for (int j = 0; j < 4; ++j) {
          const int t = tb * 16 + fq * 4 + j;
          ob[(size_t)(tokb + t) * DM + h * 128 + dv] = f2bf(oacc[tb][j] * rn[j] * gnrm * bf2f(g16[tb * 4 + j]));
        }
      }
    }
  }
}
#undef GLA_LOAD

DI int kperm(int r) { return (r & ~12) | ((r & 4) << 1) | ((r & 8) >> 1); }

__device__ void attn_item(const Params& p, const int wv, const int b, const int h, const int qt) {
  f32x16 o[4];
  float lsum = 0.f;
  {
  const int tid = tid_fresh(wv), w = tid >> 6, lane = tid & 63, lr = lane & 31, lh = lane >> 5;
  const int mp = w >> 2, wq = w & 3;
  u16* ws16 = reinterpret_cast<u16*>(p.ws);
  const u16* zb = ws16 + OFF_ZB / 2;
  const u16* kg = zb + (size_t)(b * 4096) * NIN + 2048 + h * 128;
  const u16* vg = ws16 + OFF_VTD / 2 + (size_t)((b * 4 + h) * 128) * 4096;
  const int tok = b * 4096 + qt * 128 + wq * 32 + lr;
  const int nkt_all = qt * 2 + 2;
  const int my_nkt = qt * 2 + (wq >> 1) + 1;

  bf16x8 qf[4];
#pragma unroll
  for (int ks = 0; ks < 4; ++ks)
    qf[ks] = *reinterpret_cast<const bf16x8*>(zb + (size_t)tok * NIN + 1536 + h * 128 + mp * 64 + ks * 16 + lh * 8);
#pragma unroll
  for (int bl = 0; bl < 4; ++bl)
#pragma unroll
    for (int i = 0; i < 16; ++i) o[bl][i] = 0.f;
  float mrun = 0.f;

  const u16* kp0; const u16* kp1; const u16* vp0; const u16* vp1;
  {
    const int L0 = tid, L1 = 512 + tid;
    kp0 = kg + (size_t)(L0 >> 4) * NIN + (((L0 & 15) ^ ((L0 >> 4) & 15)) * 8);
    kp1 = kg + (size_t)(L1 >> 4) * NIN + (((L1 & 15) ^ ((L1 >> 4) & 15)) * 8);
    vp0 = vg + (size_t)(L0 >> 3) * 4096 + (((L0 & 7) ^ ((L0 >> 4) & 7)) * 8);
    vp1 = vg + (size_t)(L1 >> 3) * 4096 + (((L1 & 7) ^ ((L1 >> 4) & 7)) * 8);
  }
#define ASTAGE(kt, buf) do { \
    __builtin_amdgcn_global_load_lds((const unsigned*)kp0, (unsigned*)(smem + (buf) * 16384 + tid * 16), 16, 0, 0); \
    __builtin_amdgcn_global_load_lds((const unsigned*)vp0, (unsigned*)(smem + 65536 + (buf) * 16384 + tid * 16), 16, 0, 0); \
    __builtin_amdgcn_global_load_lds((const unsigned*)kp1, (unsigned*)(smem + (buf) * 16384 + 8192 + tid * 16), 16, 0, 0); \
    __builtin_amdgcn_global_load_lds((const unsigned*)vp1, (unsigned*)(smem + 65536 + (buf) * 16384 + 8192 + tid * 16), 16, 0, 0); \
    kp0 += 64 * NIN; kp1 += 64 * NIN; vp0 += 64; vp1 += 64; \
  } while (0)

  constexpr bool late = false;
  const int koff0 = kperm(lr) * 256, kx = kperm(lr) & 15;
#define PV_STEP(VOFF) do { \
    _Pragma("unroll") for (int hb = 0; hb < 4; ++hb) { \
      bf16x8 vfr[4]; \
      _Pragma("unroll") for (int q_ = 0; q_ < 4; ++q_) { \
        const int bl = hb, s4 = q_, dvrow = bl * 32 + lr; \
        const int c = s4 * 2 + lh, ph = c ^ ((dvrow >> 1) & 7); \
        vfr[q_] = *reinterpret_cast<const bf16x8*>(smem + (VOFF) + dvrow * 128 + ph * 16); } \
      __builtin_amdgcn_sched_barrier(0); \
      _Pragma("unroll") for (int q_ = 0; q_ < 4; ++q_) { \
        const int bl = hb, s4 = q_; \
        o[bl] = __builtin_amdgcn_mfma_f32_32x32x16_bf16(vfr[q_], pf[s4], o[bl], 0, 0, 0); } \
      __builtin_amdgcn_sched_barrier(0); \
    } } while (0)
#define ATT_ITER(J) do { \
    const int kt = kt0 + (J); \
    if (kt + 1 < nkt_all) asm volatile("s_waitcnt vmcnt(4)" ::: "memory"); \
    else asm volatile("s_waitcnt vmcnt(0)" ::: "memory"); \
    __builtin_amdgcn_s_barrier(); \
    asm volatile("" ::: "memory"); \
    if (kt + 2 < nkt_all) ASTAGE(kt + 2, ((J) + 2) & 3); \
    if (late && kt >= 1 && kt - 1 < my_nkt) PV_STEP(65536 + (((J) + 3) & 3) * 16384); \
    if (kt < my_nkt) { \
      bf16x8 kfr[8]; \
      _Pragma("unroll") for (int q_ = 0; q_ < 8; ++q_) { \
        const int kb = q_ >> 2, ks = q_ & 3; \
        const int cc = mp * 8 + ks * 2 + lh, ph = cc ^ kx; \
        kfr[q_] = *reinterpret_cast<const bf16x8*>(smem + (J) * 16384 + kb * 8192 + koff0 + ph * 16); } \
      __builtin_amdgcn_sched_barrier(0); \
      f32x16 s[2]; \
      const float ninit = -mrun; \
      _Pragma("unroll") for (int kb = 0; kb < 2; ++kb) { \
        _Pragma("unroll") for (int i = 0; i < 16; ++i) s[kb][i] = ninit; \
        _Pragma("unroll") for (int ks = 0; ks < 4; ++ks) \
          s[kb] = __builtin_amdgcn_mfma_f32_32x32x16_bf16(kfr[kb * 4 + ks], qf[ks], s[kb], 0, 0, 0); } \
      __builtin_amdgcn_sched_barrier(0); \
      float mx = s[0][0]; \
      _Pragma("unroll") for (int i = 1; i < 16; ++i) mx = fmaxf(mx, s[0][i]); \
      _Pragma("unroll") for (int i = 0; i < 16; ++i) mx = fmaxf(mx, s[1][i]); \
      mx = xor32_max(mx); \
      if (kt == 0) { \
        mrun = mx; \
        _Pragma("unroll") for (int kb = 0; kb < 2; ++kb) _Pragma("unroll") for (int i = 0; i < 16; ++i) s[kb][i] -= mx; \
      } else if (__any(mx > 6.0f)) { \
        const float delta = fmaxf(mx, 0.f); \
        const float alpha = __builtin_amdgcn_exp2f(-delta); \
        mrun += delta; lsum *= alpha; \
        _Pragma("unroll") for (int bl = 0; bl < 4; ++bl) _Pragma("unroll") for (int i = 0; i < 16; ++i) o[bl][i] *= alpha; \
        _Pragma("unroll") for (int kb = 0; kb < 2; ++kb) _Pragma("unroll") for (int i = 0; i < 16; ++i) s[kb][i] -= delta; \
      } \
      float ls = lsum; \
      _Pragma("unroll") for (int s4 = 0; s4 < 4; ++s4) { \
        float v[8]; \
        _Pragma("unroll") for (int e = 0; e < 8; ++e) { v[e] = __builtin_amdgcn_exp2f(s[s4 >> 1][(s4 & 1) * 8 + e]); ls += v[e]; } \
        uint4 pk; \
        pk.x = pack2(v[0], v[1]); pk.y = pack2(v[2], v[3]); pk.z = pack2(v[4], v[5]); pk.w = pack2(v[6], v[7]); \
        pf[s4] = __builtin_bit_cast(bf16x8, pk); } \
      lsum = ls; \
      if (!late) PV_STEP(65536 + (J) * 16384); \
    } } while (0)
  bf16x8 pf[4];
#pragma unroll
  for (int i = 0; i < 4; ++i) pf[i] = bf16x8{0, 0, 0, 0, 0, 0, 0, 0};
  __syncthreads();
  ASTAGE(0, 0);
  if (nkt_all > 1) ASTAGE(1, 1);
#pragma unroll 1
  for (int kt0 = 0; kt0 < nkt_all; kt0 += 4) {
    ATT_ITER(0);
    ATT_ITER(1);
    if (kt0 + 2 < nkt_all) {
      ATT_ITER(2);
      ATT_ITER(3);
    }
  }
  if (late && nkt_all - 1 < my_nkt) {
    if ((nkt_all - 1) & 2) PV_STEP(65536 + 3 * 16384); else PV_STEP(65536 + 1 * 16384);
  }
#undef ATT_ITER
#undef PV_STEP
  __syncthreads();
#undef ASTAGE
  }
  const int tidZ = tid_fresh(wv);
  const int wZ = tidZ >> 6, lane = tidZ & 63, lh = lane >> 5, mp = wZ >> 2, wq = wZ & 3;
  const int tok = b * 4096 + qt * 128 + wq * 32 + (lane & 31);
  u16* ob = reinterpret_cast<u16*>(p.ws) + OFF_OB / 2;
  const float lt = xor32_sum(lsum);
  float lam = 0.2f;
  {
    float d1 = 0.f, d2 = 0.f;
    for (int i = 0; i < 64; ++i) { d1 += p.lq1[i] * p.lk1[i]; d2 += p.lq2[i] * p.lk2[i]; }
    lam += expf(d1) - expf(d2);
  }
  float* X = reinterpret_cast<float*>(smem);
  const float sc = (mp == 0) ? (1.0f / lt) : (lam / lt);
  if (mp == 1) {
#pragma unroll
    for (int bl = 0; bl < 4; ++bl)
#pragma unroll
      for (int i = 0; i < 16; ++i) X[(wq * 64 + bl * 16 + i) * 64 + lane] = o[bl][i] * sc;
  }
  __syncthreads();
  if (mp == 0) {
    float ss = 0.f;
#pragma unroll
    for (int bl = 0; bl < 4; ++bl)
#pragma unroll
      for (int i = 0; i < 16; ++i) {
        const float v = o[bl][i] * sc - X[(wq * 64 + bl * 16 + i) * 64 + lane];
        o[bl][i] = v;
        ss += v * v;
      }
    ss = xor32_sum(ss);
    const float rn = rsqrtf(ss * (1.0f / 128.0f) + EPS) * 0.8f;
#pragma unroll
    for (int bl = 0; bl < 4; ++bl)
#pragma unroll
      for (int g = 0; g < 4; ++g) {
        const int dv0 = bl * 32 + 8 * g + 4 * lh;
        const float4 gn = *reinterpret_cast<const float4*>(p.diff_norm + h * 128 + dv0);
        *reinterpret_cast<s16x4*>(ob + (size_t)tok * DM + 512 + h * 128 + dv0) =
            pack4(o[bl][g * 4 + 0] * rn * gn.x, o[bl][g * 4 + 1] * rn * gn.y,
                  o[bl][g * 4 + 2] * rn * gn.z, o[bl][g * 4 + 3] * rn * gn.w);
      }
  }
}

__device__ void phase_mix(const Params& p, const int wv, const int cidx, const int li_begin = 0, const int li_end = 8 + 256) {
  const int xcd = blockIdx.x & 7;
  int* cnt = reinterpret_cast<int*>(p.ws + OFF_CNT) + cidx * 8 + xcd;
  int* slot = reinterpret_cast<int*>(smem + SMEM_ITEM_OFF);
  while (true) {
    __syncthreads();
    if (tid_fresh(wv) == 0) *slot = atomicAdd(cnt, 1);
    __syncthreads();
    const int li = *slot + li_begin;
    if (li >= li_end) break;
    if (li < 8) { const int bh = xcd + 8 * li; gla_chain(p, wv, bh >> 2, bh & 3); }
    else {
      const int ai = li - 8, bh = xcd + 8 * (ai >> 5);
      attn_item(p, wv, bh >> 2, bh & 3, 31 - (ai & 31));
    }
  }
}

__device__ void phase_fixup(const Params& p, const int wv) {
  const float* halo = reinterpret_cast<const float*>(p.ws + OFF_HALO);
  u16* ab = reinterpret_cast<u16*>(p.ws) + OFF_ZB / 2;
  const int total = 256 * 2 * NFF;
  const int tidF = tid_fresh(wv);
  for (int e = blockIdx.x * 512 + tidF; e < total; e += gridDim.x * 512) {
    const int f = e % NFF, rl = (e / NFF) & 1, mtile = e / (2 * NFF);
    const int pc = (f >> 7) * 256 + (f & 127);
    const bool first = (mtile & 15) == 0;
    const float* hp = halo + (size_t)(mtile - 1) * 4 * NUP;
    const float* hc = halo + (size_t)mtile * 4 * NUP;
    const float ug0 = first ? 0.f : hp[2 * NUP + pc], uv0 = first ? 0.f : hp[2 * NUP + pc + 128];
    const float ug1 = first ? 0.f : hp[3 * NUP + pc], uv1 = first ? 0.f : hp[3 * NUP + pc + 128];
    const float ug2 = hc[pc], uv2 = hc[pc + 128];
    const float ug3 = hc[NUP + pc], uv3 = hc[NUP + pc + 128];
    const bool r0 = (rl == 0);
    const float a0 = r0 ? ug0 : ug1, a1 = r0 ? ug1 : ug2, a2 = r0 ? ug2 : ug3;
    const float c0 = r0 ? uv0 : uv1, c1 = r0 ? uv1 : uv2, c2 = r0 ? uv2 : uv3;
    const float cgv = p.conv_b[f] + p.conv_w[f] * a0 + p.conv_w[(size_t)NUP + f] * a1 + p.conv_w[(size_t)2 * NUP + f] * a2;
    const float cvv = p.conv_b[NFF + f] + p.conv_w[NFF + f] * c0 + p.conv_w[(size_t)NUP + NFF + f] * c1 + p.conv_w[(size_t)2 * NUP + NFF + f] * c2;
    ab[(size_t)(mtile * 256 + rl) * NFF + f] = f2bf(gelu_tanh(cgv) * cvv);
  }
}

__device__ void phase_final_rows(const Params& p, const int wv, const int row0) {
  const int tidF = tid_fresh(wv);
  const int wave = tidF >> 6, lane = tidF & 63;
  const float* ssq3 = reinterpret_cast<const float*>(p.ws + OFF_SSQ3);
#pragma unroll 1
  for (int rr = 0; rr < 32; ++rr) {
    const int row = row0 + wave * 32 + rr;
    const float r = rs_from(ssq3, row);
#pragma unroll
    for (int i = 0; i < 4; ++i) {
      float4* q = reinterpret_cast<float4*>(p.out + (size_t)row * DM + i * 256 + lane * 4);
      const float4 g = *reinterpret_cast<const float4*>(p.norm_final + i * 256 + lane * 4);
      float4 v = *q;
      v.x *= r * g.x; v.y *= r * g.y; v.z *= r * g.z; v.w *= r * g.w;
      *q = v;
    }
  }
}

__device__ void phase_final(const Params& p, const int wv) {
  const int tidF = tid_fresh(wv);
  const int wave = tidF >> 6, lane = tidF & 63;
  const float* ssq3 = reinterpret_cast<const float*>(p.ws + OFF_SSQ3);
  for (int row = blockIdx.x * 8 + wave; row < NTOK; row += gridDim.x * 8) {
    const float r = rs_from(ssq3, row);
#pragma unroll
    for (int i = 0; i < 4; ++i) {
      float4* q = reinterpret_cast<float4*>(p.out + (size_t)row * DM + i * 256 + lane * 4);
      const float4 g = *reinterpret_cast<const float4*>(p.norm_final + i * 256 + lane * 4);
      float4 v = *q;
      v.x *= r * g.x; v.y *= r * g.y; v.z *= r * g.z; v.w *= r * g.w;
      *q = v;
    }
  }
}

template <int EPI, bool FUSED = true>
__device__ __forceinline__ void gemm_phase(const Params& p, const int wv, const u16* A, const u16* Bt, int K, int nN, const EpiArgs& ea,
                                           int tile_begin, int tile_count) {
  constexpr bool kPrefetch = (EPI != EPI_UP) && (EPI != EPI_IN);
  bool pro = false;
  for (int t = blockIdx.x; t < tile_count; t += gridDim.x) {
    int pm, pn, qm = 0, qn = 0;
    tile_map(t, 256, nN, pm, pn);
    const bool nxt = kPrefetch && (t + (int)gridDim.x < tile_count);
    if (nxt) tile_map(t + gridDim.x, 256, nN, qm, qn);
    gemm_tile<EPI, FUSED>(A, Bt, K, pm * 256, pn * 256, p, ea, wv, pro, nxt, qm * 256, qn * 256);
    pro = nxt;
  }
  (void)tile_begin;
}

template <bool FUSED>
__global__ void __launch_bounds__(512) mega(Params p) {
  cg::grid_group grid = cg::this_grid();
  const int wv = __builtin_amdgcn_readfirstlane((int)(threadIdx.x >> 6));
  u16* ws16 = reinterpret_cast<u16*>(p.ws);
  float* ssq1 = reinterpret_cast<float*>(p.ws + OFF_SSQ1);
  float* ssq2 = reinterpret_cast<float*>(p.ws + OFF_SSQ2);
  float* ssq3 = reinterpret_cast<float*>(p.ws + OFF_SSQ3);

  volatile LAS unsigned* xst = (volatile LAS unsigned*)(smem + SMEM_ITEM_OFF + 128);
  if (tid_fresh(wv) < 2) xst[tid_fresh(wv)] = 0u;
  phase_prep(p, wv);
  grid.sync();
  const XcdBarrier xb = xcd_barrier_post(reinterpret_cast<unsigned*>(p.ws + OFF_XB), xst, wv);
#if PROBE_REP == 8
  xcd_barrier(xb, wv); grid.sync(); grid.sync(); grid.sync();
#endif
#if PROBE_REP == 7
  phase_prep(p, wv);
  xcd_barrier(xb, wv);
#endif
  { EpiArgs ea{nullptr, nullptr, nullptr};
    gemm_phase<EPI_IN>(p, wv, ws16 + OFF_U0 / 2, ws16 + OFF_WIN / 2, 1024, 12, ea, 0, 256 * 12); }
  xcd_barrier(xb, wv);
#if PROBE_REP == 10
  { EpiArgs ea{nullptr, nullptr, nullptr};
    gemm_phase<EPI_NONE>(p, wv, ws16 + OFF_U0 / 2, ws16 + OFF_WIN / 2, 1024, 12, ea, 0, 256 * 12); }
  xcd_barrier(xb, wv);
#endif
#if PROBE_REP == 5
  { EpiArgs ea{nullptr, nullptr, nullptr};
    gemm_phase<EPI_IN>(p, wv, ws16 + OFF_U0 / 2, ws16 + OFF_WIN / 2, 1024, 12, ea, 0, 256 * 12); }
  xcd_barrier(xb, wv);
#endif
  phase_mix(p, wv, 0);
  xcd_barrier(xb, wv);
#if PROBE_REP == 2
  phase_mix(p, wv, 1);
  xcd_barrier(xb, wv);
#endif
#if PROBE_REP == 6
  phase_mix(p, wv, 1, 8, 8 + 256);
  xcd_barrier(xb, wv);
#endif
#if PROBE_REP == 3
  phase_mix(p, wv, 1, 0, 8);
  xcd_barrier(xb, wv);
#endif
  { EpiArgs ea{p.x, ssq1, nullptr};
    gemm_phase<EPI_RES>(p, wv, ws16 + OFF_OB / 2, ws16 + OFF_WOUT / 2, 1024, 4, ea, 0, 256 * 4); }
  xcd_barrier(xb, wv);
#if PROBE_REP == 9
  { EpiArgs ea{nullptr, nullptr, ssq1};
    gemm_phase<EPI_NONE>(p, wv, ws16 + OFF_U0 / 2, ws16 + OFF_WUP / 2, 1024, 22, ea, 0, 256 * 22); }
  xcd_barrier(xb, wv);
#endif
  { EpiArgs ea{nullptr, nullptr, ssq1};
    gemm_phase<EPI_UP>(p, wv, ws16 + OFF_U0 / 2, ws16 + OFF_WUP / 2, 1024, 22, ea, 0, 256 * 22); }
  xcd_barrier(xb, wv);
#if PROBE_REP == 4
  { EpiArgs ea{nullptr, nullptr, ssq1};
    gemm_phase<EPI_UP>(p, wv, ws16 + OFF_U0 / 2, ws16 + OFF_WUP / 2, 1024, 22, ea, 0, 256 * 22); }
  xcd_barrier(xb, wv);
#endif
  phase_fixup(p, wv);
  xcd_barrier(xb, wv);
  { EpiArgs ea{p.out, ssq2, nullptr};
    gemm_phase<EPI_RES>(p, wv, ws16 + OFF_ZB / 2, ws16 + OFF_WDN / 2, 2816, 4, ea, 0, 256 * 4); }
  { EpiArgs ea{nullptr, nullptr, nullptr};
    gemm_phase<EPI_PP>(p, wv, ws16 + OFF_PB / 2, ws16 + OFF_WPP / 2, 256, 4, ea, 0, 256 * 4); }
  xcd_barrier(xb, wv);
  { EpiArgs ea{nullptr, ssq3, ssq2};
    gemm_phase<EPI_PLE, FUSED>(p, wv, ws16 + OFF_U0 / 2, ws16 + OFF_WPG / 2, 1024, 4, ea, 0, 256 * 4); }
  if constexpr (!FUSED) {
    xcd_barrier(xb, wv);
    phase_final(p, wv);
  }
}

extern "C" void kernel_launch(void* const* d_in, const int* in_sizes, int n_in, void* d_out, int out_size,
                              void* d_ws, size_t ws_size, hipStream_t stream) {
  static int grid_blocks = 0;
  static bool fused = true;
  if (!grid_blocks) {
    int dev = 0, cus = 0, per_cu = 0;
    (void)hipGetDevice(&dev);
    (void)hipDeviceGetAttribute(&cus, hipDeviceAttributeMultiprocessorCount, dev);
    (void)hipFuncSetAttribute((const void*)mega<true>, hipFuncAttributeMaxDynamicSharedMemorySize, SMEM_BYTES);
    (void)hipFuncSetAttribute((const void*)mega<false>, hipFuncAttributeMaxDynamicSharedMemorySize, SMEM_BYTES);
    (void)hipOccupancyMaxActiveBlocksPerMultiprocessor(&per_cu, mega<true>, 512, SMEM_BYTES);
    if (per_cu < 1) per_cu = 1;
    if (per_cu > 1) per_cu = 1;
    grid_blocks = cus * per_cu;
    fused = (grid_blocks == 256);
  }
  Params p{};
  p.x = (const float*)d_in[0]; p.p = (const float*)d_in[1]; p.pos = (const int*)d_in[2];
  p.norm_mix = (const float*)d_in[3]; p.w_in = (const float*)d_in[4]; p.w_a_up = (const float*)d_in[5];
  p.b_a = (const float*)d_in[6]; p.gla_norm = (const float*)d_in[7];
  p.lq1 = (const float*)d_in[8]; p.lk1 = (const float*)d_in[9]; p.lq2 = (const float*)d_in[10]; p.lk2 = (const float*)d_in[11];
  p.diff_norm = (const float*)d_in[12]; p.w_out = (const float*)d_in[13]; p.norm_ffn = (const float*)d_in[14];
  p.w_up = (const float*)d_in[15]; p.conv_w = (const float*)d_in[16]; p.conv_b = (const float*)d_in[17];
  p.w_down = (const float*)d_in[18]; p.norm_ple = (const float*)d_in[19]; p.w_pg = (const float*)d_in[20];
  p.w_pp = (const float*)d_in[21]; p.norm_final = (const float*)d_in[22];
  p.out = (float*)d_out; p.ws = (char*)d_ws;
  void* args[] = {&p};
  const void* fn = fused ? (const void*)mega<true> : (const void*)mega<false>;
  hipError_t e = hipLaunchCooperativeKernel(fn, dim3(grid_blocks), dim3(512), args, SMEM_BYTES, stream);
  if (e != hipSuccess) fprintf(stderr, "cooperative launch failed: %s (grid %d)\n", hipGetErrorString(e), grid_blocks);
}
```
